# Optimizing an MI355X kernel written in HIP

```python
import jax, jax.numpy as jnp
from jax import lax
import numpy as np

D_MODEL = 1024
BATCH = 4
SEQ = 4096
DEPTH = 2

N_GROUPS = 8
GROUP_DIM = D_MODEL // 16
MIX_W = N_GROUPS * GROUP_DIM
CONF_WIDTH = 31
LRU_CONV_WIDTH = 4
LRU_C = 8.0
SHORT_CONV_WIDTH = 3
MOBA_BLOCK = 256
MOBA_TOPK = 3
MOBA_QCHUNK = 32
ROPE_THETA = 10000.0
FFN_DIM = 2816
N_EXPERTS = 8
TOP_K = 2
EXPERT_DIM = 3584
EXPERT_ROWS = 256
EPS = 1e-6
N_EVEN = (DEPTH + 1) // 2
N_ODD = DEPTH // 2

kernel_name = "hybrid_conformer_rglru_shortconv_moba_moe"

F32 = jnp.float32


def rms_norm(x, g):
    x32 = x.astype(F32)
    y = x32 * lax.rsqrt(jnp.mean(x32 * x32, axis=-1, keepdims=True) + EPS)
    return (y * g.astype(F32)).astype(x.dtype)


def layer_norm(x, g, b):
    x32 = x.astype(F32)
    mu = jnp.mean(x32, axis=-1, keepdims=True)
    var = jnp.mean(jnp.square(x32 - mu), axis=-1, keepdims=True)
    y = (x32 - mu) * lax.rsqrt(var + EPS) * g.astype(F32) + b.astype(F32)
    return y.astype(x.dtype)


def causal_depthwise_conv(x, w, b=None):
    width, ch = w.shape
    xp = jnp.pad(x, ((0, 0), (width - 1, 0), (0, 0)))
    y = lax.conv_general_dilated(xp, w[:, None, :].astype(x.dtype), window_strides=(1,),
                                 padding='VALID', dimension_numbers=('NWC', 'WIO', 'NWC'),
                                 feature_group_count=ch)
    return y if b is None else y + b


def rope(x, pos):
    half = x.shape[-1] // 2
    inv = ROPE_THETA ** (-jnp.arange(half, dtype=F32) / half)
    ang = pos.astype(F32)[:, None] * inv[None, :]
    cos = jnp.cos(ang)[None, :, None, :]
    sin = jnp.sin(ang)[None, :, None, :]
    x32 = x.astype(F32)
    x1, x2 = x32[..., :half], x32[..., half:]
    return jnp.concatenate([x1 * cos - x2 * sin, x2 * cos + x1 * sin], axis=-1).astype(x.dtype)


def rg_lru(x, wa, ba, wx, bx, lam):
    bsz, s, ch = x.shape
    xg = x.reshape(bsz, s, N_GROUPS, GROUP_DIM)
    r = jax.nn.sigmoid(jnp.einsum('bshi,hij->bshj', xg, wa).reshape(bsz, s, ch) + ba)
    i = jax.nn.sigmoid(jnp.einsum('bshi,hij->bshj', xg, wx).reshape(bsz, s, ch) + bx)
    log_a = LRU_C * r.astype(F32) * jax.nn.log_sigmoid(lam.astype(F32))
    a = jnp.exp(log_a)
    mult = jnp.sqrt(-jnp.expm1(2.0 * log_a))
    bterm = mult * (i * x).astype(F32)

    def combine(left, right):
        a_l, b_l = left
        a_r, b_r = right
        return a_l * a_r, a_r * b_l + b_r

    _, h = lax.associative_scan(combine, (a, bterm), axis=1)
    return h.astype(x.dtype)


def mixer_conformer_rglru(h, w_in, conv_a_w, conv_a_b, ln_a_g, ln_a_b, conv_b_w, conv_b_b,
                          lru_wa, lru_ba, lru_wx, lru_bx, lru_lambda, w_out):
    u = h @ w_in
    a_val, a_gate, b_x, b_gate = jnp.split(u, 4, axis=-1)
    ya = a_val * jax.nn.sigmoid(a_gate)
    ya = causal_depthwise_conv(ya, conv_a_w, conv_a_b)
    ya = jax.nn.silu(layer_norm(ya, ln_a_g, ln_a_b))
    xb = causal_depthwise_conv(b_x, conv_b_w, conv_b_b)
    yb = rg_lru(xb, lru_wa, lru_ba, lru_wx, lru_bx, lru_lambda) * jax.nn.gelu(b_gate)
    return jnp.concatenate([ya, yb], axis=-1) @ w_out


def moba_attention(q, k, v):
    bsz, s, nh, dh = q.shape
    s_pad = -(-s // MOBA_BLOCK) * MOBA_BLOCK
    padw = ((0, 0), (0, s_pad - s), (0, 0), (0, 0))
    q, k, v = jnp.pad(q, padw), jnp.pad(k, padw), jnp.pad(v, padw)
    nb = s_pad // MOBA_BLOCK
    nc = s_pad // MOBA_QCHUNK
    n_topk = min(MOBA_TOPK, nb)
    scale = dh ** -0.5
    kb = k.transpose(0, 2, 1, 3).reshape(bsz, nh, nb, MOBA_BLOCK, dh)
    vb = v.transpose(0, 2, 1, 3).reshape(bsz, nh, nb, MOBA_BLOCK, dh)
    k_mean = jnp.mean(kb.astype(F32), axis=3)
    q_chunks = q.transpose(0, 2, 1, 3).reshape(bsz, nh, nc, MOBA_QCHUNK, dh).transpose(2, 0, 1, 3, 4)
    b_idx = jnp.arange(bsz)[:, None, None, None]
    h_idx = jnp.arange(nh)[None, :, None, None]
    blk_ids = jnp.arange(nb)
    slot = jnp.arange(n_topk)
    within = jnp.arange(MOBA_BLOCK)
    n_sel = n_topk * MOBA_BLOCK

    def one_chunk(args):
        qc, ci = args
        q_start = ci * MOBA_QCHUNK
        own = q_start // MOBA_BLOCK
        q_pos = q_start + jnp.arange(MOBA_QCHUNK)
        gate = jnp.einsum('bhqd,bhnd->bhqn', qc.astype(F32), k_mean)
        gate = jnp.where(blk_ids < own, gate, -jnp.inf)
        _, sel = lax.top_k(gate, n_topk)
        sel_valid = slot < own
        k_sel = kb[b_idx, h_idx, sel]
        v_sel = vb[b_idx, h_idx, sel]
        s_sel = jnp.einsum('bhqd,bhqkjd->bhqkj', qc, k_sel).astype(F32) * scale
        s_sel = jnp.where(sel_valid[:, None], s_sel, -jnp.inf)
        k_own = lax.dynamic_index_in_dim(kb, own, axis=2, keepdims=False)
        v_own = lax.dynamic_index_in_dim(vb, own, axis=2, keepdims=False)
        s_own = jnp.einsum('bhqd,bhjd->bhqj', qc, k_own).astype(F32) * scale
        causal = (own * MOBA_BLOCK + within)[None, :] <= q_pos[:, None]
        s_own = jnp.where(causal, s_own, -jnp.inf)
        scores = jnp.concatenate([s_sel.reshape(bsz, nh, MOBA_QCHUNK, n_sel), s_own], axis=-1)
        p = jax.nn.softmax(scores, axis=-1)
        p_sel = p[..., :n_sel].reshape(bsz, nh, MOBA_QCHUNK, n_topk, MOBA_BLOCK).astype(v.dtype)
        p_own = p[..., n_sel:].astype(v.dtype)
        return (jnp.einsum('bhqkj,bhqkjd->bhqd', p_sel, v_sel)
                + jnp.einsum('bhqj,bhjd->bhqd', p_own, v_own))

    out = lax.map(one_chunk, (q_chunks, jnp.arange(nc)))
    out = out.transpose(1, 0, 3, 2, 4).reshape(bsz, s_pad, nh, dh)
    return out[:, :s]


def mixer_shortconv_moba(h, w_in, conv_c_w, q_norm, k_norm, w_out, pos):
    bsz, s, _ = h.shape
    u = h @ w_in
    c_h, c_b, c_c, q, k, v = jnp.split(u, 6, axis=-1)
    yc = c_b * causal_depthwise_conv(c_c * c_h, conv_c_w)
    q = rope(rms_norm(q.reshape(bsz, s, N_GROUPS, GROUP_DIM), q_norm), pos)
    k = rope(rms_norm(k.reshape(bsz, s, N_GROUPS, GROUP_DIM), k_norm), pos)
    v = v.reshape(bsz, s, N_GROUPS, GROUP_DIM)
    yd = moba_attention(q, k, v).reshape(bsz, s, MIX_W)
    return jnp.concatenate([yc, yd], axis=-1) @ w_out


def swiglu(h, wg, wu, wd):
    return (jax.nn.silu(h @ wg) * (h @ wu)) @ wd


def moe_swiglu(h, router_w, router_b, wg, wu, wd):
    bsz, s, d = h.shape
    n_tok = bsz * s
    xf = h.reshape(n_tok, d)
    logits = xf.astype(F32) @ router_w.astype(F32) + router_b.astype(F32)
    top_logit, top_e = lax.top_k(logits, TOP_K)
    top_w = jax.nn.softmax(top_logit, axis=-1)
    n_assign = n_tok * TOP_K
    flat_e = top_e.reshape(-1)
    flat_tok = jnp.repeat(jnp.arange(n_tok, dtype=jnp.int32), TOP_K)
    flat_w = top_w.reshape(-1)
    order = jnp.argsort(flat_e)
    sorted_e = flat_e[order]
    counts = jnp.bincount(flat_e, length=N_EXPERTS)
    padded = (counts + EXPERT_ROWS - 1) // EXPERT_ROWS * EXPERT_ROWS
    start = jnp.cumsum(counts) - counts
    pend = jnp.cumsum(padded)
    pstart = pend - padded
    dest = pstart[sorted_e] + (jnp.arange(n_assign) - start[sorted_e])
    n_rows = -(-(n_assign + N_EXPERTS * (EXPERT_ROWS - 1)) // EXPERT_ROWS) * EXPERT_ROWS
    n_blocks = n_rows // EXPERT_ROWS
    row_tok = jnp.zeros((n_rows,), jnp.int32).at[dest].set(flat_tok[order])
    row_w = jnp.zeros((n_rows,), F32).at[dest].set(flat_w[order])
    blk_e = jnp.minimum(jnp.searchsorted(pend, jnp.arange(n_blocks) * EXPERT_ROWS, side='right'),
                        N_EXPERTS - 1)
    xs = xf[row_tok].reshape(n_blocks, EXPERT_ROWS, d)

    def expert_block(args):
        xb, e = args
        return (jax.nn.silu(xb @ wg[e]) * (xb @ wu[e])) @ wd[e]

    ys = lax.map(expert_block, (xs, blk_e)).reshape(n_rows, d)
    out = jnp.zeros((n_tok, d), F32).at[row_tok].add(ys.astype(F32) * row_w[:, None])
    return out.astype(h.dtype).reshape(bsz, s, d)


def setup_inputs(seed: int = 0) -> dict:
    key = jax.random.key(seed)
    ks = iter(jax.random.split(key, 48))
    D = D_MODEL

    def nrm(shape, scale):
        return jax.random.normal(next(ks), shape, jnp.float32) * scale

    a0 = jax.random.uniform(next(ks), (N_EVEN, MIX_W), jnp.float32, 0.9, 0.999)
    return {
        "x": nrm((BATCH, SEQ, D), 1.0),
        "c": nrm((BATCH, D), 1.0),
        "e_ada_w": nrm((N_EVEN, D, 6 * D), 0.5 * D ** -0.5),
        "e_ada_b": nrm((N_EVEN, 6 * D), 0.02),
        "e_norm_mix": 1.0 + nrm((N_EVEN, D), 0.05),
        "e_norm_ffn": 1.0 + nrm((N_EVEN, D), 0.05),
        "e_w_in": nrm((N_EVEN, D, 4 * MIX_W), D ** -0.5),
        "e_conv_a_w": nrm((N_EVEN, CONF_WIDTH, MIX_W), CONF_WIDTH ** -0.5),
        "e_conv_a_b": nrm((N_EVEN, MIX_W), 0.02),
        "e_ln_a_g": 1.0 + nrm((N_EVEN, MIX_W), 0.05),
        "e_ln_a_b": nrm((N_EVEN, MIX_W), 0.02),
        "e_conv_b_w": nrm((N_EVEN, LRU_CONV_WIDTH, MIX_W), LRU_CONV_WIDTH ** -0.5),
        "e_conv_b_b": nrm((N_EVEN, MIX_W), 0.02),
        "e_lru_wa": nrm((N_EVEN, N_GROUPS, GROUP_DIM, GROUP_DIM), GROUP_DIM ** -0.5),
        "e_lru_ba": nrm((N_EVEN, MIX_W), 0.02),
        "e_lru_wx": nrm((N_EVEN, N_GROUPS, GROUP_DIM, GROUP_DIM), GROUP_DIM ** -0.5),
        "e_lru_bx": nrm((N_EVEN, MIX_W), 0.02),
        "e_lru_lambda": jnp.log(a0) - jnp.log1p(-a0),
        "e_w_out": nrm((N_EVEN, 2 * MIX_W, D), (2 * MIX_W) ** -0.5),
        "e_ffn_wg": nrm((N_EVEN, D, FFN_DIM), D ** -0.5),
        "e_ffn_wu": nrm((N_EVEN, D, FFN_DIM), D ** -0.5),
        "e_ffn_wd": nrm((N_EVEN, FFN_DIM, D), FFN_DIM ** -0.5),
        "o_ada_w": nrm((N_ODD, D, 6 * D), 0.5 * D ** -0.5),
        "o_ada_b": nrm((N_ODD, 6 * D), 0.02),
        "o_norm_mix": 1.0 + nrm((N_ODD, D), 0.05),
        "o_norm_ffn": 1.0 + nrm((N_ODD, D), 0.05),
        "o_w_in": nrm((N_ODD, D, 6 * MIX_W), D ** -0.5),
        "o_conv_c_w": nrm((N_ODD, SHORT_CONV_WIDTH, MIX_W), SHORT_CONV_WIDTH ** -0.5),
        "o_q_norm": 1.0 + nrm((N_ODD, GROUP_DIM), 0.05),
        "o_k_norm": 1.0 + nrm((N_ODD, GROUP_DIM), 0.05),
        "o_w_out": nrm((N_ODD, 2 * MIX_W, D), (2 * MIX_W) ** -0.5),
        "o_router_w": nrm((N_ODD, D, N_EXPERTS), D ** -0.5),
        "o_router_b": nrm((N_ODD, N_EXPERTS), 0.01),
        "o_moe_wg": nrm((N_ODD, N_EXPERTS, D, EXPERT_DIM), D ** -0.5),
        "o_moe_wu": nrm((N_ODD, N_EXPERTS, D, EXPERT_DIM), D ** -0.5),
        "o_moe_wd": nrm((N_ODD, N_EXPERTS, EXPERT_DIM, D), EXPERT_DIM ** -0.5),
    }


def reference(x, c, e_ada_w, e_ada_b, e_norm_mix, e_norm_ffn, e_w_in, e_conv_a_w, e_conv_a_b,
              e_ln_a_g, e_ln_a_b, e_conv_b_w, e_conv_b_b, e_lru_wa, e_lru_ba, e_lru_wx, e_lru_bx,
              e_lru_lambda, e_w_out, e_ffn_wg, e_ffn_wu, e_ffn_wd,
              o_ada_w, o_ada_b, o_norm_mix, o_norm_ffn, o_w_in, o_conv_c_w, o_q_norm, o_k_norm,
              o_w_out, o_router_w, o_router_b, o_moe_wg, o_moe_wu, o_moe_wd):
    pos = jnp.arange(x.shape[1])
    c_act = jax.nn.silu(c)
    for layer in range(DEPTH):
        j = layer // 2
        if layer % 2 == 0:
            mod = (c_act @ e_ada_w[j] + e_ada_b[j])[:, None, :]
            sh1, sc1, g1, sh2, sc2, g2 = jnp.split(mod, 6, axis=-1)
            h = rms_norm(x, e_norm_mix[j]) * (1.0 + sc1) + sh1
            x = x + g1 * mixer_conformer_rglru(
                h, e_w_in[j], e_conv_a_w[j], e_conv_a_b[j], e_ln_a_g[j], e_ln_a_b[j],
                e_conv_b_w[j], e_conv_b_b[j], e_lru_wa[j], e_lru_ba[j], e_lru_wx[j], e_lru_bx[j],
                e_lru_lambda[j], e_w_out[j])
            h = rms_norm(x, e_norm_ffn[j]) * (1.0 + sc2) + sh2
            x = x + g2 * swiglu(h, e_ffn_wg[j], e_ffn_wu[j], e_ffn_wd[j])
        else:
            mod = (c_act @ o_ada_w[j] + o_ada_b[j])[:, None, :]
            sh1, sc1, g1, sh2, sc2, g2 = jnp.split(mod, 6, axis=-1)
            h = rms_norm(x, o_norm_mix[j]) * (1.0 + sc1) + sh1
            x = x + g1 * mixer_shortconv_moba(h, o_w_in[j], o_conv_c_w[j], o_q_norm[j], o_k_norm[j],
                                              o_w_out[j], pos)
            h = rms_norm(x, o_norm_ffn[j]) * (1.0 + sc2) + sh2
            x = x + g2 * moe_swiglu(h, o_router_w[j], o_router_b[j], o_moe_wg[j], o_moe_wu[j],
                                    o_moe_wd[j])
    return x
```

```cpp
#include <hip/hip_runtime.h>
#include <cstdint>
#include <cstdio>

namespace {
#define LAS __attribute__((address_space(3)))
typedef unsigned short bf16_t;
typedef short bf16x8 __attribute__((ext_vector_type(8)));
typedef float f32x4 __attribute__((ext_vector_type(4)));
typedef unsigned u32x4 __attribute__((ext_vector_type(4)));
typedef unsigned u32x2 __attribute__((ext_vector_type(2)));

constexpr int NB = 4, SEQ = 4096, DM = 1024, T = NB * SEQ;
constexpr int MIXW = 512, FFN = 2816, NE = 8, ED = 3584;
constexpr int MAXROWS = 34816;
constexpr float C2 = 0.125f * 1.4426950408889634f;

enum In { I_X = 0, I_C, E_ADA_W, E_ADA_B, E_NORM_MIX, E_NORM_FFN, E_W_IN, E_CONV_A_W, E_CONV_A_B, E_LN_A_G, E_LN_A_B, E_CONV_B_W, E_CONV_B_B,
          E_LRU_WA, E_LRU_BA, E_LRU_WX, E_LRU_BX, E_LRU_LAMBDA, E_W_OUT, E_FFN_WG, E_FFN_WU, E_FFN_WD,
          O_ADA_W, O_ADA_B, O_NORM_MIX, O_NORM_FFN, O_W_IN, O_CONV_C_W, O_Q_NORM, O_K_NORM, O_W_OUT, O_ROUTER_W, O_ROUTER_B, O_MOE_WG, O_MOE_WU, O_MOE_WD, N_IN };

constexpr size_t KiB = 1024, MiB = 1024 * 1024;
constexpr size_t WS_CTL = 0, CTL_BYTES = 128 * KiB;
constexpr size_t WS_MOD = 128 * KiB;
constexpr size_t WS_ROPE_C = 320 * KiB, WS_ROPE_S = 832 * KiB;
constexpr size_t WS_AAGG = 1344 * KiB, WS_HAGG = 1856 * KiB;
constexpr size_t WS_KPART = 2368 * KiB;
constexpr size_t WS_TOPE = 3392 * KiB, WS_TOPW = 3520 * KiB, WS_POS = 3648 * KiB;
constexpr size_t WS_EXPINFO = 3776 * KiB;
constexpr size_t WS_KMEAN = 3780 * KiB;
constexpr size_t WS_WSMALL = 4 * MiB;
constexpr size_t WS_WMOE = WS_WSMALL + 30 * MiB + 512 * KiB;
constexpr size_t WS_XS = WS_WMOE + 168 * MiB;
constexpr size_t WS_R = WS_XS + 68 * MiB;
constexpr size_t R_U = 0, R_HLP = 96 * MiB, R_Q = 96 * MiB, R_K = 112 * MiB, R_Y = 128 * MiB, R_XN = 160 * MiB, R_V = 192 * MiB, R_H = 0, R_HS = 0;
constexpr size_t WS_END = WS_R + 238 * MiB;

struct P {
    const float* in[N_IN];
    float* out;
    unsigned char* ws;
};

__device__ __forceinline__ float bf2f(unsigned v) { return __uint_as_float(v << 16); }
__device__ __forceinline__ unsigned f2bf(float f) { unsigned u = __float_as_uint(f); return (u + 0x7fffu + ((u >> 16) & 1u)) >> 16; }
__device__ __forceinline__ unsigned pk2(float lo, float hi) { return f2bf(lo) | (f2bf(hi) << 16); }
__device__ __forceinline__ float wave_sum(float v) {
#pragma unroll
    for (int o = 1; o < 64; o <<= 1) v += __shfl_xor(v, o);
    return v;
}
__device__ __forceinline__ float sigmoidf_(float x) { return 1.f / (1.f + __expf(-x)); }
__device__ __forceinline__ float gelu_tanh(float x) { const float u = 0.7978845608028654f * (x + 0.044715f * x * x * x); return 0.5f * x * (1.f + tanhf(u)); }

__device__ __forceinline__ void stage_prep(const P& p, LAS float* red  ) {
    const int tid = threadIdx.x, lane = tid & 63, wave = tid >> 6;
    float* mod = (float*)(p.ws + WS_MOD);
    for (int chunk = blockIdx.x; chunk < 192; chunk += gridDim.x) {
        const int L = chunk / 96, col0 = (chunk % 96) * 64;
        const float* W = p.in[L ? O_ADA_W : E_ADA_W]; const float* bias = p.in[L ? O_ADA_B : E_ADA_B];
        float acc[4] = {0.f, 0.f, 0.f, 0.f};
        const int k0 = wave * 128;
#pragma unroll 4
        for (int k = k0; k < k0 + 128; ++k) {
            const float w = W[(size_t)k * 6144 + col0 + lane];
#pragma unroll
            for (int b = 0; b < 4; ++b) { const float cv = p.in[I_C][b * 1024 + k]; acc[b] += (cv / (1.f + __expf(-cv))) * w; }
        }
#pragma unroll
        for (int b = 0; b < 4; ++b) red[(wave * 4 + b) * 64 + lane] = acc[b];
        __syncthreads();
        if (tid < 256) { const int b = tid >> 6, l = tid & 63; float s = bias[col0 + l];
#pragma unroll
            for (int w = 0; w < 8; ++w) s += red[(w * 4 + b) * 64 + l];
            mod[(size_t)(L * 4 + b) * 6144 + col0 + l] = s; }
        __syncthreads();
    }
    float* rc = (float*)(p.ws + WS_ROPE_C); float* rs = (float*)(p.ws + WS_ROPE_S);
    for (int i = blockIdx.x * blockDim.x + tid; i < SEQ * 32; i += gridDim.x * blockDim.x) {
        const int pos = i >> 5, d = i & 31;
        const double inv = exp(-(double)d * (1.0 / 32.0) * 9.210340371976184);
        const double ang = (double)pos * inv;
        rc[i] = (float)cos(ang); rs[i] = (float)sin(ang);
    }
}

template <bool ROUTE>
__device__ __forceinline__ void stage_norm(const P& p, const float* X, const float* nw, const float* modL, int sh_off, int sc_off, bf16_t* XN) {
    const int lane = threadIdx.x & 63, wave = threadIdx.x >> 6, nwv = blockDim.x >> 6;
    const int gw = blockIdx.x * nwv + wave, NGW = gridDim.x * nwv;
    f32x4 w4[4];
#pragma unroll
    for (int j = 0; j < 4; ++j) w4[j] = *(const f32x4*)(nw + 4 * lane + 256 * j);
    const float* rw = p.in[O_ROUTER_W]; const float* rb = p.in[O_ROUTER_B];
    int* tope = (int*)(p.ws + WS_TOPE); float* topw = (float*)(p.ws + WS_TOPW);
    for (int row = gw; row < T; row += NGW) {
        const int b = row >> 12;
        const f32x4* xr = (const f32x4*)(X + (size_t)row * DM) + lane;
        f32x4 v[4]; float ss = 0.f;
#pragma unroll
        for (int j = 0; j < 4; ++j) { v[j] = xr[64 * j]; ss += (v[j].x * v[j].x + v[j].y * v[j].y) + (v[j].z * v[j].z + v[j].w * v[j].w); }
        ss = wave_sum(ss);
        const float rstd = 1.0f / sqrtf(ss * (1.f / DM) + 1e-6f);
        const float* sc = modL + b * 6144 + sc_off; const float* sh = modL + b * 6144 + sh_off;
        float lg[8] = {0.f, 0.f, 0.f, 0.f, 0.f, 0.f, 0.f, 0.f};
#pragma unroll
        for (int j = 0; j < 4; ++j) {
            const f32x4 s4 = *(const f32x4*)(sc + 4 * lane + 256 * j), h4 = *(const f32x4*)(sh + 4 * lane + 256 * j);
            const f32x4 o = (v[j] * rstd) * w4[j] * (s4 + 1.f) + h4;
            u32x2 w; w.x = pk2(o.x, o.y); w.y = pk2(o.z, o.w);
            *(u32x2*)(XN + (size_t)row * DM + 4 * lane + 256 * j) = w;
            if (ROUTE) {
#pragma unroll
                for (int i = 0; i < 4; ++i) { const int k = 4 * lane + 256 * j + i; const f32x4 r0 = *(const f32x4*)(rw + k * 8), r1 = *(const f32x4*)(rw + k * 8 + 4);
                    lg[0] += o[i] * r0.x; lg[1] += o[i] * r0.y; lg[2] += o[i] * r0.z; lg[3] += o[i] * r0.w; lg[4] += o[i] * r1.x; lg[5] += o[i] * r1.y; lg[6] += o[i] * r1.z; lg[7] += o[i] * r1.w; }
            }
        }
        if (ROUTE) {
#pragma unroll
            for (int e = 0; e < 8; ++e) lg[e] = wave_sum(lg[e]) + rb[e];
            int e0 = 0; float l0 = lg[0];
#pragma unroll
            for (int e = 1; e < 8; ++e) if (lg[e] > l0) { l0 = lg[e]; e0 = e; }
            int e1 = -1; float l1 = -INFINITY;
#pragma unroll
            for (int e = 0; e < 8; ++e) if (e != e0 && lg[e] > l1) { l1 = lg[e]; e1 = e; }
            const float w0 = 1.f / (1.f + __expf(l1 - l0));
            if (lane == 0) { tope[row * 2] = e0; tope[row * 2 + 1] = e1; topw[row * 2] = w0; topw[row * 2 + 1] = 1.f - w0; }
        }
    }
}

constexpr int GL_WAVE_LDS = 10752;
__device__ __forceinline__ void stage_griffin_local(const P& p, LAS unsigned char* lds) {
    const int tid = threadIdx.x, lane = tid & 63, wave = __builtin_amdgcn_readfirstlane(tid >> 6);
    LAS unsigned char* wl = lds + wave * GL_WAVE_LDS;
    LAS bf16_t* XA = (LAS bf16_t*)wl;
    LAS float* ZA = (LAS float*)(wl + 2304);
    LAS float* ZX = (LAS float*)(wl + 2304 + 4160);
    const int h = wave, c = 64 * h + lane, fr = lane & 15, fq = lane >> 4;
    const float cw0 = p.in[E_CONV_B_W][c], cw1 = p.in[E_CONV_B_W][512 + c], cw2 = p.in[E_CONV_B_W][1024 + c], cw3 = p.in[E_CONV_B_W][1536 + c], cb = p.in[E_CONV_B_B][c];
    const float ba = p.in[E_LRU_BA][c], bx = p.in[E_LRU_BX][c], lam = p.in[E_LRU_LAMBDA][c];
    const float lsl = fminf(lam, 0.f) - log1pf(expf(-fabsf(lam)));
    const float c8 = 8.0f * lsl;
    bf16x8 Ba[2][4], Bx[2][4];
    { const float* wa = p.in[E_LRU_WA] + h * 4096; const float* wx = p.in[E_LRU_WX] + h * 4096;
#pragma unroll
      for (int ks = 0; ks < 2; ++ks)
#pragma unroll
          for (int nt = 0; nt < 4; ++nt)
#pragma unroll
              for (int jj = 0; jj < 8; ++jj) { const int k = 32 * ks + 8 * fq + jj, n = 16 * nt + fr;
                  Ba[ks][nt][jj] = (short)f2bf(wa[k * 64 + n]); Bx[ks][nt][jj] = (short)f2bf(wx[k * 64 + n]); } }
    const bf16_t* U = (const bf16_t*)(p.ws + WS_R + R_U);
    unsigned* HLP = (unsigned*)(p.ws + WS_R + R_HLP);
    float* Aagg = (float*)(p.ws + WS_AAGG); float* Hagg = (float*)(p.ws + WS_HAGG);
    for (int tl = blockIdx.x; tl < 256; tl += gridDim.x) {
        const int b = tl >> 6, j = tl & 63; const size_t row0 = (size_t)b * SEQ + j * 64;
        float x1 = 0.f, x2 = 0.f, x3 = 0.f;
        if (j != 0) { x1 = bf2f(U[(row0 - 1) * 2048 + 1024 + c]); x2 = bf2f(U[(row0 - 2) * 2048 + 1024 + c]); x3 = bf2f(U[(row0 - 3) * 2048 + 1024 + c]); }
        float hst = 0.f, pc = 1.f;
        for (int mt = 0; mt < 4; ++mt) {
            float xb[16];
#pragma unroll
            for (int r = 0; r < 16; ++r) { const float xn = bf2f(U[(row0 + 16 * mt + r) * 2048 + 1024 + c]);
                xb[r] = cb + cw0 * x3 + cw1 * x2 + cw2 * x1 + cw3 * xn; x3 = x2; x2 = x1; x1 = xn; XA[r * 72 + lane] = (bf16_t)f2bf(xb[r]); }
            const bf16x8 a0 = *(const LAS bf16x8*)((LAS unsigned char*)XA + fr * 144 + fq * 16);
            const bf16x8 a1 = *(const LAS bf16x8*)((LAS unsigned char*)XA + fr * 144 + fq * 16 + 64);
#pragma unroll
            for (int nt = 0; nt < 4; ++nt) {
                f32x4 za = {0.f, 0.f, 0.f, 0.f}, zx = {0.f, 0.f, 0.f, 0.f};
                za = __builtin_amdgcn_mfma_f32_16x16x32_bf16(a0, Ba[0][nt], za, 0, 0, 0); za = __builtin_amdgcn_mfma_f32_16x16x32_bf16(a1, Ba[1][nt], za, 0, 0, 0);
                zx = __builtin_amdgcn_mfma_f32_16x16x32_bf16(a0, Bx[0][nt], zx, 0, 0, 0); zx = __builtin_amdgcn_mfma_f32_16x16x32_bf16(a1, Bx[1][nt], zx, 0, 0, 0);
#pragma unroll
                for (int r4 = 0; r4 < 4; ++r4) { ZA[(4 * fq + r4) * 65 + 16 * nt + fr] = za[r4]; ZX[(4 * fq + r4) * 65 + 16 * nt + fr] = zx[r4]; }
            }
#pragma unroll
            for (int r = 0; r < 16; ++r) {
                const float rg = sigmoidf_(ZA[r * 65 + lane] + ba), ig = sigmoidf_(ZX[r * 65 + lane] + bx);
                const float la = c8 * rg, a = __expf(la), mult = sqrtf(-expm1f(2.f * la));
                hst = a * hst + mult * ig * xb[r]; pc *= a;
                HLP[(row0 + 16 * mt + r) * 512 + c] = f2bf(hst) | (f2bf(pc) << 16);
            }
        }
        Aagg[tl * 512 + c] = pc; Hagg[tl * 512 + c] = hst;
    }
}

constexpr int MF_LDS = 95 * 1024;
__device__ __forceinline__ void stage_mix0_finish(const P& p, LAS unsigned char* lds) {
    const int tid = threadIdx.x, lane = tid & 63, wave = __builtin_amdgcn_readfirstlane(tid >> 6);
    const bf16_t* U = (const bf16_t*)(p.ws + WS_R + R_U);
    const unsigned* HLP = (const unsigned*)(p.ws + WS_R + R_HLP);
    const float* Aagg = (const float*)(p.ws + WS_AAGG); const float* Hagg = (const float*)(p.ws + WS_HAGG);
    bf16_t* Y = (bf16_t*)(p.ws + WS_R + R_Y);
    LAS bf16_t* G = (LAS bf16_t*)lds;
    for (int tl = blockIdx.x; tl < 256; tl += gridDim.x) {
        const int b = tl >> 6, j = tl & 63; const size_t row0 = (size_t)b * SEQ + j * 64;
        for (int idx = tid; idx < 95 * 64; idx += 512) {
            const int rho = idx >> 6, ch8 = (idx & 63) * 8, tpos = j * 64 - 30 + rho;
            u32x4 o = {0u, 0u, 0u, 0u};
            if (tpos >= 0 && rho < 94) { const size_t row = (size_t)b * SEQ + tpos;
                const u32x4 av = *(const u32x4*)(U + row * 2048 + ch8), gv = *(const u32x4*)(U + row * 2048 + 512 + ch8);
#pragma unroll
                for (int i = 0; i < 4; ++i) { const float a0 = bf2f(av[i] & 0xffffu), a1 = bf2f(av[i] >> 16), g0 = bf2f(gv[i] & 0xffffu), g1 = bf2f(gv[i] >> 16);
                    o[i] = pk2(a0 * sigmoidf_(g0), a1 * sigmoidf_(g1)); } }
            *(LAS u32x4*)(G + rho * 512 + ch8) = o;
        }
        { const int c = tid; float carry = 0.f;
          for (int jj = 0; jj < j; ++jj) carry = Aagg[(b * 64 + jj) * 512 + c] * carry + Hagg[(b * 64 + jj) * 512 + c];
#pragma unroll 8
          for (int r = 0; r < 64; ++r) { const size_t row = row0 + r; const unsigned hp = HLP[row * 512 + c];
              const float hv = bf2f(hp & 0xffffu) + bf2f(hp >> 16) * carry; const float g = bf2f(U[row * 2048 + 1536 + c]);
              Y[row * 1024 + 512 + c] = (bf16_t)f2bf(hv * gelu_tanh(g)); } }
        __syncthreads();
        f32x4 res[2][8];
#pragma unroll
        for (int ps = 0; ps < 2; ++ps) {
            const int c0 = 256 * ps + 4 * lane;
            const f32x4 bias = *(const f32x4*)(p.in[E_CONV_A_B] + c0);
#pragma unroll
            for (int o = 0; o < 8; ++o) res[ps][o] = bias;
#pragma unroll 1
            for (int jb = 0; jb < 32; jb += 8) {
                f32x4 wv[8], xw[15];
#pragma unroll
                for (int t = 0; t < 8; ++t) { const int jj = jb + t; wv[t] = *(const f32x4*)(p.in[E_CONV_A_W] + (jj < 30 ? jj : 30) * 512 + c0) * (jj <= 30 ? 1.f : 0.f); }
#pragma unroll
                for (int r = 0; r < 15; ++r) { const u32x2 raw = *(const LAS u32x2*)(G + (8 * wave + jb + r) * 512 + c0);
                    xw[r] = (f32x4){bf2f(raw.x & 0xffffu), bf2f(raw.x >> 16), bf2f(raw.y & 0xffffu), bf2f(raw.y >> 16)}; }
#pragma unroll
                for (int o = 0; o < 8; ++o)
#pragma unroll
                    for (int t = 0; t < 8; ++t) res[ps][o] += wv[t] * xw[o + t];
            }
        }
        { const f32x4 g0 = *(const f32x4*)(p.in[E_LN_A_G] + 4 * lane), g1 = *(const f32x4*)(p.in[E_LN_A_G] + 256 + 4 * lane);
          const f32x4 b0 = *(const f32x4*)(p.in[E_LN_A_B] + 4 * lane), b1 = *(const f32x4*)(p.in[E_LN_A_B] + 256 + 4 * lane);
#pragma unroll
          for (int o = 0; o < 8; ++o) {
              float s = (res[0][o].x + res[0][o].y) + (res[0][o].z + res[0][o].w) + (res[1][o].x + res[1][o].y) + (res[1][o].z + res[1][o].w);
              const float mean = wave_sum(s) * (1.f / 512.f);
              const f32x4 d0 = res[0][o] - mean, d1 = res[1][o] - mean;
              float q = (d0.x * d0.x + d0.y * d0.y) + (d0.z * d0.z + d0.w * d0.w) + (d1.x * d1.x + d1.y * d1.y) + (d1.z * d1.z + d1.w * d1.w);
              const float rstd = 1.0f / sqrtf(wave_sum(q) * (1.f / 512.f) + 1e-6f);
              f32x4 y0 = d0 * rstd * g0 + b0, y1 = d1 * rstd * g1 + b1;
              const size_t row = row0 + 8 * wave + o;
              u32x2 w0, w1;
              w0.x = pk2(y0.x * sigmoidf_(y0.x), y0.y * sigmoidf_(y0.y)); w0.y = pk2(y0.z * sigmoidf_(y0.z), y0.w * sigmoidf_(y0.w));
              w1.x = pk2(y1.x * sigmoidf_(y1.x), y1.y * sigmoidf_(y1.y)); w1.y = pk2(y1.z * sigmoidf_(y1.z), y1.w * sigmoidf_(y1.w));
              *(u32x2*)(Y + row * 1024 + 4 * lane) = w0; *(u32x2*)(Y + row * 1024 + 256 + 4 * lane) = w1;
          } }
        __syncthreads();
    }
}

__device__ __forceinline__ void stage_qkpost(const P& p) {
    const int lane = threadIdx.x & 63, wave = threadIdx.x >> 6, nwv = blockDim.x >> 6;
    const int gw = blockIdx.x * nwv + wave, NGW = gridDim.x * nwv;
    const bf16_t* U = (const bf16_t*)(p.ws + WS_R + R_U);
    bf16_t* Q = (bf16_t*)(p.ws + WS_R + R_Q); bf16_t* K = (bf16_t*)(p.ws + WS_R + R_K); bf16_t* V = (bf16_t*)(p.ws + WS_R + R_V);
    float* kpart = (float*)(p.ws + WS_KPART);
    const float* rc = (const float*)(p.ws + WS_ROPE_C); const float* rs = (const float*)(p.ws + WS_ROPE_S);
    const int i8 = lane & 7, dd = 8 * (i8 & 3); const bool hi = i8 >= 4;
    float qn[8], kn[8];
#pragma unroll
    for (int i = 0; i < 8; ++i) { qn[i] = p.in[O_Q_NORM][8 * i8 + i]; kn[i] = p.in[O_K_NORM][8 * i8 + i]; }
    for (int g = gw; g < T / 32; g += NGW) {
        float ksum[8] = {0.f, 0.f, 0.f, 0.f, 0.f, 0.f, 0.f, 0.f};
        for (int r = 0; r < 32; ++r) {
            const size_t row = (size_t)g * 32 + r; const int pos = (int)(row & (SEQ - 1));
            const f32x4 c0 = *(const f32x4*)(rc + pos * 32 + dd), c1 = *(const f32x4*)(rc + pos * 32 + dd + 4);
            const f32x4 s0 = *(const f32x4*)(rs + pos * 32 + dd), s1 = *(const f32x4*)(rs + pos * 32 + dd + 4);
            const float cs[8] = {c0.x, c0.y, c0.z, c0.w, c1.x, c1.y, c1.z, c1.w}, sn[8] = {s0.x, s0.y, s0.z, s0.w, s1.x, s1.y, s1.z, s1.w};
#pragma unroll
            for (int which = 0; which < 2; ++which) {
                const u32x4 raw = *(const u32x4*)(U + row * 3072 + 1536 + 512 * which + 8 * lane);
                float v[8];
#pragma unroll
                for (int i = 0; i < 4; ++i) { v[2 * i] = bf2f(raw[i] & 0xffffu); v[2 * i + 1] = bf2f(raw[i] >> 16); }
                float ss = 0.f;
#pragma unroll
                for (int i = 0; i < 8; ++i) ss += v[i] * v[i];
                ss += __shfl_xor(ss, 1); ss += __shfl_xor(ss, 2); ss += __shfl_xor(ss, 4);
                const float rstd = 1.0f / sqrtf(ss * (1.f / 64.f) + 1e-6f);
                float o[8];
#pragma unroll
                for (int i = 0; i < 8; ++i) { v[i] = v[i] * rstd * (which ? kn[i] : qn[i]); }
#pragma unroll
                for (int i = 0; i < 8; ++i) { const float pv = __shfl_xor(v[i], 4); o[i] = hi ? (v[i] * cs[i] + pv * sn[i]) : (v[i] * cs[i] - pv * sn[i]); }
                u32x4 w;
                if (which == 0) {
#pragma unroll
                    for (int i = 0; i < 4; ++i) w[i] = pk2(o[2 * i] * C2, o[2 * i + 1] * C2);
                    *(u32x4*)(Q + row * 512 + 8 * lane) = w;
                } else {
#pragma unroll
                    for (int i = 0; i < 8; ++i) ksum[i] += o[i];
#pragma unroll
                    for (int i = 0; i < 4; ++i) w[i] = pk2(o[2 * i], o[2 * i + 1]);
                    *(u32x4*)(K + row * 512 + 8 * lane) = w;
                }
            }
            *(u32x4*)(V + row * 512 + 8 * lane) = *(const u32x4*)(U + row * 3072 + 2560 + 8 * lane);
        }
        *(f32x4*)(kpart + (size_t)g * 512 + 8 * lane) = (f32x4){ksum[0], ksum[1], ksum[2], ksum[3]};
        *(f32x4*)(kpart + (size_t)g * 512 + 8 * lane + 4) = (f32x4){ksum[4], ksum[5], ksum[6], ksum[7]};
    }
}

__device__ __forceinline__ void stage_shortconv(const P& p) {
    const bf16_t* U = (const bf16_t*)(p.ws + WS_R + R_U);
    bf16_t* Y = (bf16_t*)(p.ws + WS_R + R_Y);
    const float* cw = p.in[O_CONV_C_W];
    for (int idx = blockIdx.x * blockDim.x + threadIdx.x; idx < T * 64; idx += gridDim.x * blockDim.x) {
        const size_t row = idx >> 6; const int ch8 = (idx & 63) * 8, pos = (int)(row & (SEQ - 1));
        float acc[8] = {0.f, 0.f, 0.f, 0.f, 0.f, 0.f, 0.f, 0.f};
#pragma unroll
        for (int jj = 0; jj < 3; ++jj) {
            if (pos - 2 + jj < 0) continue;
            const size_t r2 = row - 2 + jj;
            const u32x4 hv = *(const u32x4*)(U + r2 * 3072 + ch8), cv = *(const u32x4*)(U + r2 * 3072 + 1024 + ch8);
            const f32x4 wa = *(const f32x4*)(cw + jj * 512 + ch8), wb = *(const f32x4*)(cw + jj * 512 + ch8 + 4);
            const float w[8] = {wa.x, wa.y, wa.z, wa.w, wb.x, wb.y, wb.z, wb.w};
#pragma unroll
            for (int i = 0; i < 4; ++i) { acc[2 * i] += w[2 * i] * (bf2f(hv[i] & 0xffffu) * bf2f(cv[i] & 0xffffu)); acc[2 * i + 1] += w[2 * i + 1] * (bf2f(hv[i] >> 16) * bf2f(cv[i] >> 16)); }
        }
        const u32x4 bv = *(const u32x4*)(U + row * 3072 + 512 + ch8);
        u32x4 o;
#pragma unroll
        for (int i = 0; i < 4; ++i) o[i] = pk2(acc[2 * i] * bf2f(bv[i] & 0xffffu), acc[2 * i + 1] * bf2f(bv[i] >> 16));
        *(u32x4*)(Y + row * 1024 + ch8) = o;
    }
}

__device__ __forceinline__ void stage_route_assign(const P& p, LAS int* li  ) {
    const int tid = threadIdx.x, lane = tid & 63;
    const int* tope = (const int*)(p.ws + WS_TOPE); int* posk = (int*)(p.ws + WS_POS); int* info = (int*)(p.ws + WS_EXPINFO);
    const bf16_t* XN = (const bf16_t*)(p.ws + WS_R + R_XN); bf16_t* Xs = (bf16_t*)(p.ws + WS_XS);
    LAS int* tot = li; LAS int* bef = li + 8; LAS int* base = li + 16; LAS int* lpos = li + 64;
    for (int chunk = blockIdx.x; chunk < 256; chunk += gridDim.x) {
        if (tid < 16) li[tid] = 0;
        __syncthreads();
        int ct[8] = {0, 0, 0, 0, 0, 0, 0, 0}, cb[8] = {0, 0, 0, 0, 0, 0, 0, 0};
        for (int tok = tid; tok < T; tok += 512) {
            const int e0 = tope[tok * 2], e1 = tope[tok * 2 + 1]; const bool before = tok < chunk * 64;
#pragma unroll
            for (int e = 0; e < 8; ++e) {
                ct[e] += __popcll(__ballot(e0 == e)) + __popcll(__ballot(e1 == e));
                cb[e] += __popcll(__ballot(before && e0 == e)) + __popcll(__ballot(before && e1 == e));
            }
        }
        if (lane == 0) {
#pragma unroll
            for (int e = 0; e < 8; ++e) { atomicAdd((int*)&tot[e], ct[e]); atomicAdd((int*)&bef[e], cb[e]); }
        }
        __syncthreads();
        if (tid == 0) {
            int run = 0; int pst[8], pad[8];
#pragma unroll
            for (int e = 0; e < 8; ++e) { pad[e] = (tot[e] + 255) / 256 * 256; pst[e] = run; run += pad[e]; base[e] = pst[e] + bef[e]; }
            if (chunk == 0) { info[0] = run / 256; info[1] = run;
                for (int blk = 0; blk < run / 256; ++blk) { int ee = 7;
#pragma unroll
                    for (int e = 7; e >= 0; --e) if (blk * 256 < pst[e] + pad[e]) ee = e;
                    info[16 + blk] = ee; } }
            for (int t = 0; t < 64; ++t) { const int tok = chunk * 64 + t;
                for (int k = 0; k < 2; ++k) { const int e = tope[tok * 2 + k]; const int ps = base[e]; base[e] = ps + 1; posk[tok * 2 + k] = ps; lpos[t * 2 + k] = ps; } }
        }
        __syncthreads();
        for (int idx = tid; idx < 128 * 128; idx += 512) { const int a = idx >> 7, ch = idx & 127; const int tok = chunk * 64 + (a >> 1); const int ps = lpos[a];
            *(u32x4*)(Xs + (size_t)ps * 1024 + ch * 8) = *(const u32x4*)(XN + (size_t)tok * 1024 + ch * 8); }
        __syncthreads();
    }
}

__device__ __forceinline__ void stage_combine(const P& p) {
    const int lane = threadIdx.x & 63, wave = threadIdx.x >> 6, nwv = blockDim.x >> 6;
    const int gw = blockIdx.x * nwv + wave, NGW = gridDim.x * nwv;
    const int* posk = (const int*)(p.ws + WS_POS); const float* topw = (const float*)(p.ws + WS_TOPW);
    const bf16_t* Ys = (const bf16_t*)(p.ws + WS_XS); const float* modO = (const float*)(p.ws + WS_MOD) + 4 * 6144;
    for (int row = gw; row < T; row += NGW) {
        const int b = row >> 12; const int p0 = posk[row * 2], p1 = posk[row * 2 + 1]; const float w0 = topw[row * 2], w1 = topw[row * 2 + 1];
#pragma unroll
        for (int j = 0; j < 4; ++j) { const int col = 4 * lane + 256 * j;
            const u32x2 a = *(const u32x2*)(Ys + (size_t)p0 * 1024 + col), c = *(const u32x2*)(Ys + (size_t)p1 * 1024 + col);
            const f32x4 g = *(const f32x4*)(modO + b * 6144 + 5120 + col);
            f32x4 x = *(const f32x4*)(p.out + (size_t)row * DM + col);
            f32x4 m; m.x = w0 * bf2f(a.x & 0xffffu) + w1 * bf2f(c.x & 0xffffu); m.y = w0 * bf2f(a.x >> 16) + w1 * bf2f(c.x >> 16);
            m.z = w0 * bf2f(a.y & 0xffffu) + w1 * bf2f(c.y & 0xffffu); m.w = w0 * bf2f(a.y >> 16) + w1 * bf2f(c.y >> 16);
            *(f32x4*)(p.out + (size_t)row * DM + col) = x + g * m; }
    }
}

__global__ __launch_bounds__(512) void k_prep(P p) { __shared__ float red[2048]; stage_prep(p, (LAS float*)red); }
template <bool ROUTE> __global__ __launch_bounds__(512) void k_norm(P p, const float* X, int nw_idx, int layer, int sh_off, int sc_off) {
    stage_norm<ROUTE>(p, X, p.in[nw_idx], (const float*)(p.ws + WS_MOD) + layer * 4 * 6144, sh_off, sc_off, (bf16_t*)(p.ws + WS_R + R_XN)); }
__global__ __launch_bounds__(512) void k_griffin(P p) { extern __shared__ __attribute__((aligned(16))) unsigned char lds[]; stage_griffin_local(p, (LAS unsigned char*)lds); }
__global__ __launch_bounds__(512) void k_mix0(P p) { extern __shared__ __attribute__((aligned(16))) unsigned char lds[]; stage_mix0_finish(p, (LAS unsigned char*)lds); }
__global__ __launch_bounds__(512) void k_qkpost(P p) { stage_qkpost(p); }
__global__ __launch_bounds__(512) void k_shortconv(P p) { stage_shortconv(p); }
__global__ __launch_bounds__(512) void k_route(P p) { __shared__ int li[256]; stage_route_assign(p, (LAS int*)li); }
__global__ __launch_bounds__(512) void k_combine(P p) { stage_combine(p); }
__global__ __launch_bounds__(256) void k_kmean(P p) {
    const float* kpart = (const float*)(p.ws + WS_KPART); float* km = (float*)(p.ws + WS_KMEAN);
    const int i = blockIdx.x * 256 + threadIdx.x; if (i >= 4 * 16 * 512) return;
    const int col = i & 511, blk = i >> 9; float s = 0.f;
    for (int k = 0; k < 8; ++k) s += kpart[(size_t)(blk * 8 + k) * 512 + col];
    km[i] = s * (1.f / 256.f);
}

__global__ __launch_bounds__(64) void k_moba_naive(P p) {
    const bf16_t* Q = (const bf16_t*)(p.ws + WS_R + R_Q); const bf16_t* K = (const bf16_t*)(p.ws + WS_R + R_K); const bf16_t* V = (const bf16_t*)(p.ws + WS_R + R_V);
    const float* km = (const float*)(p.ws + WS_KMEAN); bf16_t* Y = (bf16_t*)(p.ws + WS_R + R_Y);
    const int idx = blockIdx.x * 64 + threadIdx.x; const int s = idx & 4095, bh = idx >> 12, h = bh & 7, b = bh >> 3;
    const size_t row = (size_t)b * SEQ + s; const int own = s >> 8;
    float q[64];
#pragma unroll
    for (int d = 0; d < 64; ++d) q[d] = bf2f(Q[row * 512 + h * 64 + d]);
    int s0 = -1, s1 = -1, s2 = -1; float g0 = -INFINITY, g1 = -INFINITY, g2 = -INFINITY;
    for (int n = 0; n < own; ++n) { float g = 0.f; const float* kmr = km + (size_t)(b * 16 + n) * 512 + h * 64;
#pragma unroll
        for (int d = 0; d < 64; ++d) g += q[d] * kmr[d];
        if (g > g0) { g2 = g1; s2 = s1; g1 = g0; s1 = s0; g0 = g; s0 = n; } else if (g > g1) { g2 = g1; s2 = s1; g1 = g; s1 = n; } else if (g > g2) { g2 = g; s2 = n; } }
    float m = -INFINITY, l = 0.f, o[64];
#pragma unroll
    for (int d = 0; d < 64; ++d) o[d] = 0.f;
    for (int pass = 0; pass < 4; ++pass) {
        int blk, nk;
        if (pass == 0) { blk = s0; nk = 256; } else if (pass == 1) { blk = s1; nk = 256; } else if (pass == 2) { blk = s2; nk = 256; } else { blk = own; nk = (s & 255) + 1; }
        if (blk < 0) continue;
        for (int jk = 0; jk < nk; ++jk) { const size_t kr = ((size_t)b * SEQ + blk * 256 + jk) * 512 + h * 64; float sc = 0.f;
#pragma unroll
            for (int d8 = 0; d8 < 8; ++d8) { const u32x4 kv = *(const u32x4*)(K + kr + d8 * 8);
#pragma unroll
                for (int i = 0; i < 4; ++i) { sc += q[d8 * 8 + 2 * i] * bf2f(kv[i] & 0xffffu); sc += q[d8 * 8 + 2 * i + 1] * bf2f(kv[i] >> 16); } }
            const float mn = fmaxf(m, sc), corr = exp2f(m - mn), pp = exp2f(sc - mn); l = l * corr + pp; m = mn;
#pragma unroll
            for (int d8 = 0; d8 < 8; ++d8) { const u32x4 vv = *(const u32x4*)(V + kr + d8 * 8);
#pragma unroll
                for (int i = 0; i < 4; ++i) { o[d8 * 8 + 2 * i] = o[d8 * 8 + 2 * i] * corr + pp * bf2f(vv[i] & 0xffffu); o[d8 * 8 + 2 * i + 1] = o[d8 * 8 + 2 * i + 1] * corr + pp * bf2f(vv[i] >> 16); } }
        }
    }
    const float il = 1.f / l;
#pragma unroll
    for (int d = 0; d < 64; ++d) Y[row * 1024 + 512 + h * 64 + d] = (bf16_t)f2bf(o[d] * il);
}

struct EpiStoreBf16 { bf16_t* O; int ldo; __device__ __forceinline__ void operator()(int row, int col, float v, float) const { O[(size_t)row * ldo + col] = (bf16_t)f2bf(v); } };
struct EpiResid { const float* Xin; float* Xout; const float* gate; __device__ __forceinline__ void operator()(int row, int col, float v, float) const {
    Xout[(size_t)row * DM + col] = Xin[(size_t)row * DM + col] + gate[(row >> 12) * 6144 + col] * v; } };
struct EpiSwiglu { bf16_t* O; int ldo; __device__ __forceinline__ void operator()(int row, int col, float g, float u) const { O[(size_t)row * ldo + col] = (bf16_t)f2bf(g * sigmoidf_(g) * u); } };

template <class Epi, bool DUAL>
__global__ __launch_bounds__(256) void k_gemm_naive(const bf16_t* A, int lda, const float* W0, const float* W1, int ldw, int K, Epi epi, const int* info, size_t wstride) {
    __shared__ float As[8][128]; __shared__ float Ws0[8][128]; __shared__ float Ws1[DUAL ? 8 : 1][128];
    const int tid = threadIdx.x, bm = blockIdx.y * 128, bn = blockIdx.x * 128;
    if (info) { if (bm >= info[1]) return; const int e = info[16 + (bm >> 8)]; W0 += (size_t)e * wstride; if (DUAL) W1 += (size_t)e * wstride; }
    const int tx = tid & 15, ty = tid >> 4;
    float acc0[8][8], acc1[DUAL ? 8 : 1][8];
#pragma unroll
    for (int i = 0; i < 8; ++i)
#pragma unroll
        for (int j = 0; j < 8; ++j) { acc0[i][j] = 0.f; if (DUAL) acc1[i][j] = 0.f; }
    const int ar = tid >> 1, ak = (tid & 1) * 4, wk = tid >> 5, wn = (tid & 31) * 4;
    for (int k0 = 0; k0 < K; k0 += 8) {
        const u32x2 av = *(const u32x2*)(A + (size_t)(bm + ar) * lda + k0 + ak);
        As[ak][ar] = bf2f(av.x & 0xffffu); As[ak + 1][ar] = bf2f(av.x >> 16); As[ak + 2][ar] = bf2f(av.y & 0xffffu); As[ak + 3][ar] = bf2f(av.y >> 16);
        *(f32x4*)&Ws0[wk][wn] = *(const f32x4*)(W0 + (size_t)(k0 + wk) * ldw + bn + wn);
        if (DUAL) *(f32x4*)&Ws1[wk][wn] = *(const f32x4*)(W1 + (size_t)(k0 + wk) * ldw + bn + wn);
        __syncthreads();
#pragma unroll
        for (int kk = 0; kk < 8; ++kk) {
            float a[8], b0[8], b1[8];
#pragma unroll
            for (int i = 0; i < 8; ++i) { a[i] = As[kk][ty * 8 + i]; b0[i] = Ws0[kk][tx * 8 + i]; if (DUAL) b1[i] = Ws1[kk][tx * 8 + i]; }
#pragma unroll
            for (int i = 0; i < 8; ++i)
#pragma unroll
                for (int j = 0; j < 8; ++j) { acc0[i][j] += a[i] * b0[j]; if (DUAL) acc1[i][j] += a[i] * b1[j]; }
        }
        __syncthreads();
    }
#pragma unroll
    for (int i = 0; i < 8; ++i)
#pragma unroll
        for (int j = 0; j < 8; ++j) epi(bm + ty * 8 + i, bn + tx * 8 + j, acc0[i][j], DUAL ? acc1[i][j] : 0.f);
}
}

extern "C" void kernel_launch(void* const* d_in, const int* in_sizes, int n_in, void* d_out, int out_size, void* d_ws, size_t ws_size, hipStream_t stream) {
    if (n_in != N_IN || ws_size < WS_END) { fprintf(stderr, "kernel_launch: n_in %d ws %zu need %zu\n", n_in, ws_size, (size_t)WS_END); return; }
    P p{};
    for (int i = 0; i < N_IN; ++i) p.in[i] = (const float*)d_in[i];
    p.out = (float*)d_out; p.ws = (unsigned char*)d_ws;
    unsigned char* ws = p.ws;
    bf16_t* XN = (bf16_t*)(ws + WS_R + R_XN); bf16_t* U = (bf16_t*)(ws + WS_R + R_U); bf16_t* Y = (bf16_t*)(ws + WS_R + R_Y); bf16_t* H = (bf16_t*)(ws + WS_R + R_H);
    bf16_t* Xs = (bf16_t*)(ws + WS_XS); bf16_t* Hs = (bf16_t*)(ws + WS_R + R_HS);
    const float* modE = (const float*)(ws + WS_MOD); const float* modO = modE + 4 * 6144;
    const int* info = (const int*)(ws + WS_EXPINFO);
    hipMemsetAsync(ws + WS_CTL, 0, CTL_BYTES, stream);
    hipLaunchKernelGGL(k_prep, dim3(256), dim3(512), 0, stream, p);
    hipLaunchKernelGGL(k_norm<false>, dim3(256), dim3(512), 0, stream, p, p.in[I_X], (int)E_NORM_MIX, 0, 0, 1024);
    hipLaunchKernelGGL((k_gemm_naive<EpiStoreBf16, false>), dim3(2048 / 128, T / 128), dim3(256), 0, stream, XN, DM, p.in[E_W_IN], (const float*)nullptr, 2048, DM, EpiStoreBf16{U, 2048}, (const int*)nullptr, (size_t)0);
    hipFuncSetAttribute((const void*)k_griffin, hipFuncAttributeMaxDynamicSharedMemorySize, 8 * GL_WAVE_LDS);
    hipLaunchKernelGGL(k_griffin, dim3(256), dim3(512), 8 * GL_WAVE_LDS, stream, p);
    hipFuncSetAttribute((const void*)k_mix0, hipFuncAttributeMaxDynamicSharedMemorySize, MF_LDS);
    hipLaunchKernelGGL(k_mix0, dim3(256), dim3(512), MF_LDS, stream, p);
    hipLaunchKernelGGL((k_gemm_naive<EpiResid, false>), dim3(DM / 128, T / 128), dim3(256), 0, stream, Y, DM, p.in[E_W_OUT], (const float*)nullptr, DM, DM, EpiResid{p.in[I_X], p.out, modE + 2048}, (const int*)nullptr, (size_t)0);
    hipLaunchKernelGGL(k_norm<false>, dim3(256), dim3(512), 0, stream, p, (const float*)p.out, (int)E_NORM_FFN, 0, 3072, 4096);
    hipLaunchKernelGGL((k_gemm_naive<EpiSwiglu, true>), dim3(FFN / 128, T / 128), dim3(256), 0, stream, XN, DM, p.in[E_FFN_WG], p.in[E_FFN_WU], FFN, DM, EpiSwiglu{H, FFN}, (const int*)nullptr, (size_t)0);
    hipLaunchKernelGGL((k_gemm_naive<EpiResid, false>), dim3(DM / 128, T / 128), dim3(256), 0, stream, H, FFN, p.in[E_FFN_WD], (const float*)nullptr, DM, FFN, EpiResid{p.out, p.out, modE + 5120}, (const int*)nullptr, (size_t)0);
    hipLaunchKernelGGL(k_norm<false>, dim3(256), dim3(512), 0, stream, p, (const float*)p.out, (int)O_NORM_MIX, 1, 0, 1024);
    hipLaunchKernelGGL((k_gemm_naive<EpiStoreBf16, false>), dim3(3072 / 128, T / 128), dim3(256), 0, stream, XN, DM, p.in[O_W_IN], (const float*)nullptr, 3072, DM, EpiStoreBf16{U, 3072}, (const int*)nullptr, (size_t)0);
    hipLaunchKernelGGL(k_qkpost, dim3(256), dim3(512), 0, stream, p);
    hipLaunchKernelGGL(k_kmean, dim3(128), dim3(256), 0, stream, p);
    hipLaunchKernelGGL(k_shortconv, dim3(1024), dim3(512), 0, stream, p);
    hipLaunchKernelGGL(k_moba_naive, dim3(NB * 8 * SEQ / 64), dim3(64), 0, stream, p);
    hipLaunchKernelGGL((k_gemm_naive<EpiResid, false>), dim3(DM / 128, T / 128), dim3(256), 0, stream, Y, DM, p.in[O_W_OUT], (const float*)nullptr, DM, DM, EpiResid{p.out, p.out, modO + 2048}, (const int*)nullptr, (size_t)0);
    hipLaunchKernelGGL(k_norm<true>, dim3(256), dim3(512), 0, stream, p, (const float*)p.out, (int)O_NORM_FFN, 1, 3072, 4096);
    hipLaunchKernelGGL(k_route, dim3(256), dim3(512), 0, stream, p);
    hipLaunchKernelGGL((k_gemm_naive<EpiSwiglu, true>), dim3(ED / 128, MAXROWS / 128), dim3(256), 0, stream, Xs, DM, p.in[O_MOE_WG], p.in[O_MOE_WU], ED, DM, EpiSwiglu{Hs, ED}, info, (size_t)DM * ED);
    hipLaunchKernelGGL((k_gemm_naive<EpiStoreBf16, false>), dim3(DM / 128, MAXROWS / 128), dim3(256), 0, stream, Hs, ED, p.in[O_MOE_WD], (const float*)nullptr, DM, ED, EpiStoreBf16{Xs, DM}, info, (size_t)ED * DM);
    hipLaunchKernelGGL(k_combine, dim3(256), dim3(512), 0, stream, p);
}
```

```cpp
#include <hip/hip_runtime.h>
#include <cstdint>
#include <cstdio>

#define LAS __attribute__((address_space(3)))
typedef unsigned short bf16_t;
typedef short bf16x8 __attribute__((ext_vector_type(8)));
typedef float f32x4 __attribute__((ext_vector_type(4)));
typedef unsigned u32x4 __attribute__((ext_vector_type(4)));
typedef unsigned u32x2 __attribute__((ext_vector_type(2)));

constexpr int NB = 4, SEQ = 4096, DM = 1024, T = NB * SEQ;
constexpr int MIXW = 512, FFN = 2816, NE = 8, ED = 3584;
constexpr int MAXROWS = 34816;
constexpr float C2 = 0.125f * 1.4426950408889634f;

enum In { I_X = 0, I_C, E_ADA_W, E_ADA_B, E_NORM_MIX, E_NORM_FFN, E_W_IN, E_CONV_A_W, E_CONV_A_B, E_LN_A_G, E_LN_A_B, E_CONV_B_W, E_CONV_B_B,
          E_LRU_WA, E_LRU_BA, E_LRU_WX, E_LRU_BX, E_LRU_LAMBDA, E_W_OUT, E_FFN_WG, E_FFN_WU, E_FFN_WD,
          O_ADA_W, O_ADA_B, O_NORM_MIX, O_NORM_FFN, O_W_IN, O_CONV_C_W, O_Q_NORM, O_K_NORM, O_W_OUT, O_ROUTER_W, O_ROUTER_B, O_MOE_WG, O_MOE_WU, O_MOE_WD, N_IN };

constexpr size_t KiB = 1024, MiB = 1024 * 1024;
constexpr size_t WS_CTL = 0, CTL_BYTES = 128 * KiB;
constexpr size_t WS_MOD = 128 * KiB;
constexpr size_t WS_ROPE_C = 320 * KiB, WS_ROPE_S = 832 * KiB;
constexpr size_t WS_AAGG = 1344 * KiB, WS_HAGG = 1856 * KiB;
constexpr size_t WS_KPART = 2368 * KiB;
constexpr size_t WS_TOPE = 3392 * KiB, WS_TOPW = 3520 * KiB, WS_POS = 3648 * KiB;
constexpr size_t WS_EXPINFO = 3776 * KiB;
constexpr size_t WS_KMEAN = 3780 * KiB;
constexpr size_t WS_WSMALL = 4 * MiB;
constexpr size_t WS_WMOE = WS_WSMALL + 30 * MiB + 512 * KiB;
constexpr size_t WS_XS = WS_WMOE + 168 * MiB;
constexpr size_t WS_R = WS_XS + 68 * MiB;
constexpr size_t R_U = 0, R_HLP = 96 * MiB, R_Q = 96 * MiB, R_K = 112 * MiB, R_Y = 128 * MiB, R_XN = 160 * MiB, R_V = 192 * MiB, R_H = 0, R_HS = 0;
constexpr size_t WS_END = WS_R + 238 * MiB;

struct P {
    const float* in[N_IN];
    float* out;
    unsigned char* ws;
};

__device__ __forceinline__ float bf2f(unsigned v) { return __uint_as_float(v << 16); }
__device__ __forceinline__ unsigned f2bf(float f) { unsigned u = __float_as_uint(f); return (u + 0x7fffu + ((u >> 16) & 1u)) >> 16; }
__device__ __forceinline__ unsigned pk2(float lo, float hi) { return f2bf(lo) | (f2bf(hi) << 16); }
__device__ __forceinline__ float wave_sum(float v) {
#pragma unroll
    for (int o = 1; o < 64; o <<= 1) v += __shfl_xor(v, o);
    return v;
}
__device__ __forceinline__ float sigmoidf_(float x) { return 1.f / (1.f + __expf(-x)); }
__device__ __forceinline__ float gelu_tanh(float x) { const float u = 0.7978845608028654f * (x + 0.044715f * x * x * x); return 0.5f * x * (1.f + tanhf(u)); }

__device__ __forceinline__ void stage_prep(const P& p, LAS float* red  ) {
    const int tid = threadIdx.x, lane = tid & 63, wave = tid >> 6;
    float* mod = (float*)(p.ws + WS_MOD);
    for (int chunk = blockIdx.x; chunk < 192; chunk += gridDim.x) {
        const int L = chunk / 96, col0 = (chunk % 96) * 64;
        const float* W = p.in[L ? O_ADA_W : E_ADA_W]; const float* bias = p.in[L ? O_ADA_B : E_ADA_B];
        float acc[4] = {0.f, 0.f, 0.f, 0.f};
        const int k0 = wave * 128;
#pragma unroll 4
        for (int k = k0; k < k0 + 128; ++k) {
            const float w = W[(size_t)k * 6144 + col0 + lane];
#pragma unroll
            for (int b = 0; b < 4; ++b) { const float cv = p.in[I_C][b * 1024 + k]; acc[b] += (cv / (1.f + __expf(-cv))) * w; }
        }
#pragma unroll
        for (int b = 0; b < 4; ++b) red[(wave * 4 + b) * 64 + lane] = acc[b];
        __syncthreads();
        if (tid < 256) { const int b = tid >> 6, l = tid & 63; float s = bias[col0 + l];
#pragma unroll
            for (int w = 0; w < 8; ++w) s += red[(w * 4 + b) * 64 + l];
            mod[(size_t)(L * 4 + b) * 6144 + col0 + l] = s; }
        __syncthreads();
    }
    float* rc = (float*)(p.ws + WS_ROPE_C); float* rs = (float*)(p.ws + WS_ROPE_S);
    for (int i = blockIdx.x * blockDim.x + tid; i < SEQ * 32; i += gridDim.x * blockDim.x) {
        const int pos = i >> 5, d = i & 31;
        const double inv = exp(-(double)d * (1.0 / 32.0) * 9.210340371976184);
        const double ang = (double)pos * inv;
        rc[i] = (float)cos(ang); rs[i] = (float)sin(ang);
    }
}

template <bool ROUTE>
__device__ __forceinline__ void stage_norm(const P& p, const float* X, const float* nw, const float* modL, int sh_off, int sc_off, bf16_t* XN) {
    const int lane = threadIdx.x & 63, wave = threadIdx.x >> 6, nwv = blockDim.x >> 6;
    const int gw = blockIdx.x * nwv + wave, NGW = gridDim.x * nwv;
    f32x4 w4[4];
#pragma unroll
    for (int j = 0; j < 4; ++j) w4[j] = *(const f32x4*)(nw + 4 * lane + 256 * j);
    const float* rw = p.in[O_ROUTER_W]; const float* rb = p.in[O_ROUTER_B];
    int* tope = (int*)(p.ws + WS_TOPE); float* topw = (float*)(p.ws + WS_TOPW);
    for (int row = gw; row < T; row += NGW) {
        const int b = row >> 12;
        const f32x4* xr = (const f32x4*)(X + (size_t)row * DM) + lane;
        f32x4 v[4]; float ss = 0.f;
#pragma unroll
        for (int j = 0; j < 4; ++j) { v[j] = xr[64 * j]; ss += (v[j].x * v[j].x + v[j].y * v[j].y) + (v[j].z * v[j].z + v[j].w * v[j].w); }
        ss = wave_sum(ss);
        const float rstd = 1.0f / sqrtf(ss * (1.f / DM) + 1e-6f);
        const float* sc = modL + b * 6144 + sc_off; const float* sh = modL + b * 6144 + sh_off;
        float lg[8] = {0.f, 0.f, 0.f, 0.f, 0.f, 0.f, 0.f, 0.f};
#pragma unroll
        for (int j = 0; j < 4; ++j) {
            const f32x4 s4 = *(const f32x4*)(sc + 4 * lane + 256 * j), h4 = *(const f32x4*)(sh + 4 * lane + 256 * j);
            const f32x4 o = (v[j] * rstd) * w4[j] * (s4 + 1.f) + h4;
            u32x2 w; w.x = pk2(o.x, o.y); w.y = pk2(o.z, o.w);
            *(u32x2*)(XN + (size_t)row * DM + 4 * lane + 256 * j) = w;
            if (ROUTE) {
#pragma unroll
                for (int i = 0; i < 4; ++i) { const int k = 4 * lane + 256 * j + i; const f32x4 r0 = *(const f32x4*)(rw + k * 8), r1 = *(const f32x4*)(rw + k * 8 + 4);
                    lg[0] += o[i] * r0.x; lg[1] += o[i] * r0.y; lg[2] += o[i] * r0.z; lg[3] += o[i] * r0.w; lg[4] += o[i] * r1.x; lg[5] += o[i] * r1.y; lg[6] += o[i] * r1.z; lg[7] += o[i] * r1.w; }
            }
        }
        if (ROUTE) {
#pragma unroll
            for (int e = 0; e < 8; ++e) lg[e] = wave_sum(lg[e]) + rb[e];
            int e0 = 0; float l0 = lg[0];
#pragma unroll
            for (int e = 1; e < 8; ++e) if (lg[e] > l0) { l0 = lg[e]; e0 = e; }
            int e1 = -1; float l1 = -INFINITY;
#pragma unroll
            for (int e = 0; e < 8; ++e) if (e != e0 && lg[e] > l1) { l1 = lg[e]; e1 = e; }
            const float w0 = 1.f / (1.f + __expf(l1 - l0));
            if (lane == 0) { tope[row * 2] = e0; tope[row * 2 + 1] = e1; topw[row * 2] = w0; topw[row * 2 + 1] = 1.f - w0; }
        }
    }
}

constexpr int GL_WAVE_LDS = 10752;
__device__ __forceinline__ void stage_griffin_local(const P& p, LAS unsigned char* lds) {
    const int tid = threadIdx.x, lane = tid & 63, wave = __builtin_amdgcn_readfirstlane(tid >> 6);
    LAS unsigned char* wl = lds + wave * GL_WAVE_LDS;
    LAS bf16_t* XA = (LAS bf16_t*)wl;
    LAS float* ZA = (LAS float*)(wl + 2304);
    LAS float* ZX = (LAS float*)(wl + 2304 + 4160);
    const int h = wave, c = 64 * h + lane, fr = lane & 15, fq = lane >> 4;
    const float cw0 = p.in[E_CONV_B_W][c], cw1 = p.in[E_CONV_B_W][512 + c], cw2 = p.in[E_CONV_B_W][1024 + c], cw3 = p.in[E_CONV_B_W][1536 + c], cb = p.in[E_CONV_B_B][c];
    const float ba = p.in[E_LRU_BA][c], bx = p.in[E_LRU_BX][c], lam = p.in[E_LRU_LAMBDA][c];
    const float lsl = fminf(lam, 0.f) - log1pf(expf(-fabsf(lam)));
    const float c8 = 8.0f * lsl;
    bf16x8 Ba[2][4], Bx[2][4];
    { const float* wa = p.in[E_LRU_WA] + h * 4096; const float* wx = p.in[E_LRU_WX] + h * 4096;
#pragma unroll
      for (int ks = 0; ks < 2; ++ks)
#pragma unroll
          for (int nt = 0; nt < 4; ++nt)
#pragma unroll
              for (int jj = 0; jj < 8; ++jj) { const int k = 32 * ks + 8 * fq + jj, n = 16 * nt + fr;
                  Ba[ks][nt][jj] = (short)f2bf(wa[k * 64 + n]); Bx[ks][nt][jj] = (short)f2bf(wx[k * 64 + n]); } }
    const bf16_t* U = (const bf16_t*)(p.ws + WS_R + R_U);
    unsigned* HLP = (unsigned*)(p.ws + WS_R + R_HLP);
    float* Aagg = (float*)(p.ws + WS_AAGG); float* Hagg = (float*)(p.ws + WS_HAGG);
    for (int tl = blockIdx.x; tl < 256; tl += gridDim.x) {
        const int b = tl >> 6, j = tl & 63; const size_t row0 = (size_t)b * SEQ + j * 64;
        float x1 = 0.f, x2 = 0.f, x3 = 0.f;
        if (j != 0) { x1 = bf2f(U[(row0 - 1) * 2048 + 1024 + c]); x2 = bf2f(U[(row0 - 2) * 2048 + 1024 + c]); x3 = bf2f(U[(row0 - 3) * 2048 + 1024 + c]); }
        float hst = 0.f, pc = 1.f;
        for (int mt = 0; mt < 4; ++mt) {
            float xb[16];
#pragma unroll
            for (int r = 0; r < 16; ++r) { const float xn = bf2f(U[(row0 + 16 * mt + r) * 2048 + 1024 + c]);
                xb[r] = cb + cw0 * x3 + cw1 * x2 + cw2 * x1 + cw3 * xn; x3 = x2; x2 = x1; x1 = xn; XA[r * 72 + lane] = (bf16_t)f2bf(xb[r]); }
            const bf16x8 a0 = *(const LAS bf16x8*)((LAS unsigned char*)XA + fr * 144 + fq * 16);
            const bf16x8 a1 = *(const LAS bf16x8*)((LAS unsigned char*)XA + fr * 144 + fq * 16 + 64);
#pragma unroll
            for (int nt = 0; nt < 4; ++nt) {
                f32x4 za = {0.f, 0.f, 0.f, 0.f}, zx = {0.f, 0.f, 0.f, 0.f};
                za = __builtin_amdgcn_mfma_f32_16x16x32_bf16(a0, Ba[0][nt], za, 0, 0, 0); za = __builtin_amdgcn_mfma_f32_16x16x32_bf16(a1, Ba[1][nt], za, 0, 0, 0);
                zx = __builtin_amdgcn_mfma_f32_16x16x32_bf16(a0, Bx[0][nt], zx, 0, 0, 0); zx = __builtin_amdgcn_mfma_f32_16x16x32_bf16(a1, Bx[1][nt], zx, 0, 0, 0);
#pragma unroll
                for (int r4 = 0; r4 < 4; ++r4) { ZA[(4 * fq + r4) * 65 + 16 * nt + fr] = za[r4]; ZX[(4 * fq + r4) * 65 + 16 * nt + fr] = zx[r4]; }
            }
#pragma unroll
            for (int r = 0; r < 16; ++r) {
                const float rg = sigmoidf_(ZA[r * 65 + lane] + ba), ig = sigmoidf_(ZX[r * 65 + lane] + bx);
                const float la = c8 * rg, a = __expf(la), mult = sqrtf(-expm1f(2.f * la));
                hst = a * hst + mult * ig * xb[r]; pc *= a;
                HLP[(row0 + 16 * mt + r) * 512 + c] = f2bf(hst) | (f2bf(pc) << 16);
            }
        }
        Aagg[tl * 512 + c] = pc; Hagg[tl * 512 + c] = hst;
    }
}

constexpr int MF_LDS = 95 * 1024;
__device__ __forceinline__ void stage_mix0_finish(const P& p, LAS unsigned char* lds) {
    const int tid = threadIdx.x, lane = tid & 63, wave = __builtin_amdgcn_readfirstlane(tid >> 6);
    const bf16_t* U = (const bf16_t*)(p.ws + WS_R + R_U);
    const unsigned* HLP = (const unsigned*)(p.ws + WS_R + R_HLP);
    const float* Aagg = (const float*)(p.ws + WS_AAGG); const float* Hagg = (const float*)(p.ws + WS_HAGG);
    bf16_t* Y = (bf16_t*)(p.ws + WS_R + R_Y);
    LAS bf16_t* G = (LAS bf16_t*)lds;
    for (int tl = blockIdx.x; tl < 256; tl += gridDim.x) {
        const int b = tl >> 6, j = tl & 63; const size_t row0 = (size_t)b * SEQ + j * 64;
        for (int idx = tid; idx < 95 * 64; idx += 512) {
            const int rho = idx >> 6, ch8 = (idx & 63) * 8, tpos = j * 64 - 30 + rho;
            u32x4 o = {0u, 0u, 0u, 0u};
            if (tpos >= 0 && rho < 94) { const size_t row = (size_t)b * SEQ + tpos;
                const u32x4 av = *(const u32x4*)(U + row * 2048 + ch8), gv = *(const u32x4*)(U + row * 2048 + 512 + ch8);
#pragma unroll
                for (int i = 0; i < 4; ++i) { const float a0 = bf2f(av[i] & 0xffffu), a1 = bf2f(av[i] >> 16), g0 = bf2f(gv[i] & 0xffffu), g1 = bf2f(gv[i] >> 16);
                    o[i] = pk2(a0 * sigmoidf_(g0), a1 * sigmoidf_(g1)); } }
            *(LAS u32x4*)(G + rho * 512 + ch8) = o;
        }
        { const int c = tid; float carry = 0.f;
          for (int jj = 0; jj < j; ++jj) carry = Aagg[(b * 64 + jj) * 512 + c] * carry + Hagg[(b * 64 + jj) * 512 + c];
#pragma unroll 8
          for (int r = 0; r < 64; ++r) { const size_t row = row0 + r; const unsigned hp = HLP[row * 512 + c];
              const float hv = bf2f(hp & 0xffffu) + bf2f(hp >> 16) * carry; const float g = bf2f(U[row * 2048 + 1536 + c]);
              Y[row * 1024 + 512 + c] = (bf16_t)f2bf(hv * gelu_tanh(g)); } }
        __syncthreads();
        f32x4 res[2][8];
#pragma unroll
        for (int ps = 0; ps < 2; ++ps) {
            const int c0 = 256 * ps + 4 * lane;
            const f32x4 bias = *(const f32x4*)(p.in[E_CONV_A_B] + c0);
#pragma unroll
            for (int o = 0; o < 8; ++o) res[ps][o] = bias;
#pragma unroll 1
            for (int jb = 0; jb < 32; jb += 8) {
                f32x4 wv[8], xw[15];
#pragma unroll
                for (int t = 0; t < 8; ++t) { const int jj = jb + t; wv[t] = *(const f32x4*)(p.in[E_CONV_A_W] + (jj < 30 ? jj : 30) * 512 + c0) * (jj <= 30 ? 1.f : 0.f); }
#pragma unroll
                for (int r = 0; r < 15; ++r) { const u32x2 raw = *(const LAS u32x2*)(G + (8 * wave + jb + r) * 512 + c0);
                    xw[r] = (f32x4){bf2f(raw.x & 0xffffu), bf2f(raw.x >> 16), bf2f(raw.y & 0xffffu), bf2f(raw.y >> 16)}; }
#pragma unroll
                for (int o = 0; o < 8; ++o)
#pragma unroll
                    for (int t = 0; t < 8; ++t) res[ps][o] += wv[t] * xw[o + t];
            }
        }
        { const f32x4 g0 = *(const f32x4*)(p.in[E_LN_A_G] + 4 * lane), g1 = *(const f32x4*)(p.in[E_LN_A_G] + 256 + 4 * lane);
          const f32x4 b0 = *(const f32x4*)(p.in[E_LN_A_B] + 4 * lane), b1 = *(const f32x4*)(p.in[E_LN_A_B] + 256 + 4 * lane);
#pragma unroll
          for (int o = 0; o < 8; ++o) {
              float s = (res[0][o].x + res[0][o].y) + (res[0][o].z + res[0][o].w) + (res[1][o].x + res[1][o].y) + (res[1][o].z + res[1][o].w);
              const float mean = wave_sum(s) * (1.f / 512.f);
              const f32x4 d0 = res[0][o] - mean, d1 = res[1][o] - mean;
              float q = (d0.x * d0.x + d0.y * d0.y) + (d0.z * d0.z + d0.w * d0.w) + (d1.x * d1.x + d1.y * d1.y) + (d1.z * d1.z + d1.w * d1.w);
              const float rstd = 1.0f / sqrtf(wave_sum(q) * (1.f / 512.f) + 1e-6f);
              f32x4 y0 = d0 * rstd * g0 + b0, y1 = d1 * rstd * g1 + b1;
              const size_t row = row0 + 8 * wave + o;
              u32x2 w0, w1;
              w0.x = pk2(y0.x * sigmoidf_(y0.x), y0.y * sigmoidf_(y0.y)); w0.y = pk2(y0.z * sigmoidf_(y0.z), y0.w * sigmoidf_(y0.w));
              w1.x = pk2(y1.x * sigmoidf_(y1.x), y1.y * sigmoidf_(y1.y)); w1.y = pk2(y1.z * sigmoidf_(y1.z), y1.w * sigmoidf_(y1.w));
              *(u32x2*)(Y + row * 1024 + 4 * lane) = w0; *(u32x2*)(Y + row * 1024 + 256 + 4 * lane) = w1;
          } }
        __syncthreads();
    }
}

__device__ __forceinline__ void stage_qkpost(const P& p) {
    const int lane = threadIdx.x & 63, wave = threadIdx.x >> 6, nwv = blockDim.x >> 6;
    const int gw = blockIdx.x * nwv + wave, NGW = gridDim.x * nwv;
    const bf16_t* U = (const bf16_t*)(p.ws + WS_R + R_U);
    bf16_t* Q = (bf16_t*)(p.ws + WS_R + R_Q); bf16_t* K = (bf16_t*)(p.ws + WS_R + R_K); bf16_t* V = (bf16_t*)(p.ws + WS_R + R_V);
    float* kpart = (float*)(p.ws + WS_KPART);
    const float* rc = (const float*)(p.ws + WS_ROPE_C); const float* rs = (const float*)(p.ws + WS_ROPE_S);
    const int i8 = lane & 7, dd = 8 * (i8 & 3); const bool hi = i8 >= 4;
    float qn[8], kn[8];
#pragma unroll
    for (int i = 0; i < 8; ++i) { qn[i] = p.in[O_Q_NORM][8 * i8 + i]; kn[i] = p.in[O_K_NORM][8 * i8 + i]; }
    for (int g = gw; g < T / 32; g += NGW) {
        float ksum[8] = {0.f, 0.f, 0.f, 0.f, 0.f, 0.f, 0.f, 0.f};
        for (int r = 0; r < 32; ++r) {
            const size_t row = (size_t)g * 32 + r; const int pos = (int)(row & (SEQ - 1));
            const f32x4 c0 = *(const f32x4*)(rc + pos * 32 + dd), c1 = *(const f32x4*)(rc + pos * 32 + dd + 4);
            const f32x4 s0 = *(const f32x4*)(rs + pos * 32 + dd), s1 = *(const f32x4*)(rs + pos * 32 + dd + 4);
            const float cs[8] = {c0.x, c0.y, c0.z, c0.w, c1.x, c1.y, c1.z, c1.w}, sn[8] = {s0.x, s0.y, s0.z, s0.w, s1.x, s1.y, s1.z, s1.w};
#pragma unroll
            for (int which = 0; which < 2; ++which) {
                const u32x4 raw = *(const u32x4*)(U + row * 3072 + 1536 + 512 * which + 8 * lane);
                float v[8];
#pragma unroll
                for (int i = 0; i < 4; ++i) { v[2 * i] = bf2f(raw[i] & 0xffffu); v[2 * i + 1] = bf2f(raw[i] >> 16); }
                float ss = 0.f;
#pragma unroll
                for (int i = 0; i < 8; ++i) ss += v[i] * v[i];
                ss += __shfl_xor(ss, 1); ss += __shfl_xor(ss, 2); ss += __shfl_xor(ss, 4);
                const float rstd = 1.0f / sqrtf(ss * (1.f / 64.f) + 1e-6f);
                float o[8];
#pragma unroll
                for (int i = 0; i < 8; ++i) { v[i] = v[i] * rstd * (which ? kn[i] : qn[i]); }
#pragma unroll
                for (int i = 0; i < 8; ++i) { const float pv = __shfl_xor(v[i], 4); o[i] = hi ? (v[i] * cs[i] + pv * sn[i]) : (v[i] * cs[i] - pv * sn[i]); }
                u32x4 w;
                if (which == 0) {
#pragma unroll
                    for (int i = 0; i < 4; ++i) w[i] = pk2(o[2 * i] * C2, o[2 * i + 1] * C2);
                    *(u32x4*)(Q + row * 512 + 8 * lane) = w;
                } else {
#pragma unroll
                    for (int i = 0; i < 8; ++i) ksum[i] += o[i];
#pragma unroll
                    for (int i = 0; i < 4; ++i) w[i] = pk2(o[2 * i], o[2 * i + 1]);
                    *(u32x4*)(K + row * 512 + 8 * lane) = w;
                }
            }
            *(u32x4*)(V + row * 512 + 8 * lane) = *(const u32x4*)(U + row * 3072 + 2560 + 8 * lane);
        }
        *(f32x4*)(kpart + (size_t)g * 512 + 8 * lane) = (f32x4){ksum[0], ksum[1], ksum[2], ksum[3]};
        *(f32x4*)(kpart + (size_t)g * 512 + 8 * lane + 4) = (f32x4){ksum[4], ksum[5], ksum[6], ksum[7]};
    }
}

__device__ __forceinline__ void stage_shortconv(const P& p) {
    const bf16_t* U = (const bf16_t*)(p.ws + WS_R + R_U);
    bf16_t* Y = (bf16_t*)(p.ws + WS_R + R_Y);
    const float* cw = p.in[O_CONV_C_W];
    for (int idx = blockIdx.x * blockDim.x + threadIdx.x; idx < T * 64; idx += gridDim.x * blockDim.x) {
        const size_t row = idx >> 6; const int ch8 = (idx & 63) * 8, pos = (int)(row & (SEQ - 1));
        float acc[8] = {0.f, 0.f, 0.f, 0.f, 0.f, 0.f, 0.f, 0.f};
#pragma unroll
        for (int jj = 0; jj < 3; ++jj) {
            if (pos - 2 + jj < 0) continue;
            const size_t r2 = row - 2 + jj;
            const u32x4 hv = *(const u32x4*)(U + r2 * 3072 + ch8), cv = *(const u32x4*)(U + r2 * 3072 + 1024 + ch8);
            const f32x4 wa = *(const f32x4*)(cw + jj * 512 + ch8), wb = *(const f32x4*)(cw + jj * 512 + ch8 + 4);
            const float w[8] = {wa.x, wa.y, wa.z, wa.w, wb.x, wb.y, wb.z, wb.w};
#pragma unroll
            for (int i = 0; i < 4; ++i) { acc[2 * i] += w[2 * i] * (bf2f(hv[i] & 0xffffu) * bf2f(cv[i] & 0xffffu)); acc[2 * i + 1] += w[2 * i + 1] * (bf2f(hv[i] >> 16) * bf2f(cv[i] >> 16)); }
        }
        const u32x4 bv = *(const u32x4*)(U + row * 3072 + 512 + ch8);
        u32x4 o;
#pragma unroll
        for (int i = 0; i < 4; ++i) o[i] = pk2(acc[2 * i] * bf2f(bv[i] & 0xffffu), acc[2 * i + 1] * bf2f(bv[i] >> 16));
        *(u32x4*)(Y + row * 1024 + ch8) = o;
    }
}

__device__ __forceinline__ void stage_route_assign(const P& p, LAS int* li  ) {
    const int tid = threadIdx.x, lane = tid & 63;
    const int* tope = (const int*)(p.ws + WS_TOPE); int* posk = (int*)(p.ws + WS_POS); int* info = (int*)(p.ws + WS_EXPINFO);
    const bf16_t* XN = (const bf16_t*)(p.ws + WS_R + R_XN); bf16_t* Xs = (bf16_t*)(p.ws + WS_XS);
    LAS int* tot = li; LAS int* bef = li + 8; LAS int* base = li + 16; LAS int* lpos = li + 64;
    for (int chunk = blockIdx.x; chunk < 256; chunk += gridDim.x) {
        if (tid < 16) li[tid] = 0;
        __syncthreads();
        int ct[8] = {0, 0, 0, 0, 0, 0, 0, 0}, cb[8] = {0, 0, 0, 0, 0, 0, 0, 0};
        for (int tok = tid; tok < T; tok += 512) {
            const int e0 = tope[tok * 2], e1 = tope[tok * 2 + 1]; const bool before = tok < chunk * 64;
#pragma unroll
            for (int e = 0; e < 8; ++e) {
                ct[e] += __popcll(__ballot(e0 == e)) + __popcll(__ballot(e1 == e));
                cb[e] += __popcll(__ballot(before && e0 == e)) + __popcll(__ballot(before && e1 == e));
            }
        }
        if (lane == 0) {
#pragma unroll
            for (int e = 0; e < 8; ++e) { atomicAdd((int*)&tot[e], ct[e]); atomicAdd((int*)&bef[e], cb[e]); }
        }
        __syncthreads();
        if (tid == 0) {
            int run = 0; int pst[8], pad[8];
#pragma unroll
            for (int e = 0; e < 8; ++e) { pad[e] = (tot[e] + 255) / 256 * 256; pst[e] = run; run += pad[e]; base[e] = pst[e] + bef[e]; }
            if (chunk == 0) { info[0] = run / 256; info[1] = run;
                for (int blk = 0; blk < run / 256; ++blk) { int ee = 7;
#pragma unroll
                    for (int e = 7; e >= 0; --e) if (blk * 256 < pst[e] + pad[e]) ee = e;
                    info[16 + blk] = ee; } }
            for (int t = 0; t < 64; ++t) { const int tok = chunk * 64 + t;
                for (int k = 0; k < 2; ++k) { const int e = tope[tok * 2 + k]; const int ps = base[e]; base[e] = ps + 1; posk[tok * 2 + k] = ps; lpos[t * 2 + k] = ps; } }
        }
        __syncthreads();
        for (int idx = tid; idx < 128 * 128; idx += 512) { const int a = idx >> 7, ch = idx & 127; const int tok = chunk * 64 + (a >> 1); const int ps = lpos[a];
            *(u32x4*)(Xs + (size_t)ps * 1024 + ch * 8) = *(const u32x4*)(XN + (size_t)tok * 1024 + ch * 8); }
        __syncthreads();
    }
}

__device__ __forceinline__ void stage_combine(const P& p) {
    const int lane = threadIdx.x & 63, wave = threadIdx.x >> 6, nwv = blockDim.x >> 6;
    const int gw = blockIdx.x * nwv + wave, NGW = gridDim.x * nwv;
    const int* posk = (const int*)(p.ws + WS_POS); const float* topw = (const float*)(p.ws + WS_TOPW);
    const bf16_t* Ys = (const bf16_t*)(p.ws + WS_XS); const float* modO = (const float*)(p.ws + WS_MOD) + 4 * 6144;
    for (int row = gw; row < T; row += NGW) {
        const int b = row >> 12; const int p0 = posk[row * 2], p1 = posk[row * 2 + 1]; const float w0 = topw[row * 2], w1 = topw[row * 2 + 1];
#pragma unroll
        for (int j = 0; j < 4; ++j) { const int col = 4 * lane + 256 * j;
            const u32x2 a = *(const u32x2*)(Ys + (size_t)p0 * 1024 + col), c = *(const u32x2*)(Ys + (size_t)p1 * 1024 + col);
            const f32x4 g = *(const f32x4*)(modO + b * 6144 + 5120 + col);
            f32x4 x = *(const f32x4*)(p.out + (size_t)row * DM + col);
            f32x4 m; m.x = w0 * bf2f(a.x & 0xffffu) + w1 * bf2f(c.x & 0xffffu); m.y = w0 * bf2f(a.x >> 16) + w1 * bf2f(c.x >> 16);
            m.z = w0 * bf2f(a.y & 0xffffu) + w1 * bf2f(c.y & 0xffffu); m.w = w0 * bf2f(a.y >> 16) + w1 * bf2f(c.y >> 16);
            *(f32x4*)(p.out + (size_t)row * DM + col) = x + g * m; }
    }
}


constexpr int NWAVES = 8;
constexpr int RING_BYTES = 131072, LDSCTL_OFF = RING_BYTES, MISC_OFF = LDSCTL_OFF + 320, LDS_BYTES = 147456;
constexpr int CW_BAR = 1024;
typedef __attribute__((address_space(1))) unsigned gu32;
#define RLX_AGENT __ATOMIC_RELAXED, __HIP_MEMORY_SCOPE_AGENT
namespace pg8 {
#define PG8_LAS __attribute__((address_space(3)))
typedef unsigned short bf16_t;
typedef short bf16x8 __attribute__((ext_vector_type(8)));
typedef float f32x4 __attribute__((ext_vector_type(4)));
typedef unsigned u32x4 __attribute__((ext_vector_type(4)));
constexpr int BM = 256, BK = 64, HALF = 128, HTB = HALF * BK * 2  , STAGE_BYTES = 8 * HTB, NXCD = 8, WGM = 8;

__host__ __device__ __forceinline__ int lds_byte(int r, int c) { const int st = (r >> 4) * 2 + (c >> 5), rr = r & 15, cc = c & 31, ob = rr * 64 + cc * 2; return st * 1024 + (ob ^ (((ob >> 9) & 1) << 5)); }
__host__ __device__ __forceinline__ void stage_rc(int b, int& R, int& C) { const int st = b / 1024, sb = b % 1024, swz = sb ^ (((sb >> 9) & 1) << 5); R = (st >> 1) * 16 + swz / 64; C = (st & 1) * 32 + (swz % 64) / 2; }
__host__ __device__ __forceinline__ int perm32(int rho) { const int n = rho >> 4, i = rho & 15; return 8 * (i >> 2) + 4 * n + (i & 3); }

struct Unit { int pm, pn, bt; };
struct Gemm { const bf16_t* A; const bf16_t* Bt; int M, N, K; };

struct StaticOrder {
    int nM, nN, nwg, G, c;
    __host__ __device__ void init(int M, int N, int G_, int c_) { nM = M / BM; nN = N / BM; nwg = nM * nN; G = G_; c = c_; }
    __host__ __device__ bool next(int i, Unit& u) const {
        const long L = (long)i * G + c; if (L >= nwg) return false;
        int wgid = (int)L; { const int q = nwg / NXCD, r = nwg % NXCD, xcd = wgid % NXCD, off = wgid / NXCD; wgid = (xcd < r ? xcd * (q + 1) : r * (q + 1) + (xcd - r) * q) + off; }
        const int nig = WGM * nN, gid = wgid / nig, fm = gid * WGM, gsz = (nM - fm) < WGM ? (nM - fm) : WGM;
        u.pm = fm + ((wgid % nig) % gsz); u.pn = (wgid % nig) / gsz; u.bt = u.pn; return true;
    }
    __device__ __forceinline__ void a_ready(const Unit&) const {}
    __device__ __forceinline__ void done(const Unit&) const {}
};

__device__ __forceinline__ unsigned cvt_pk_bf16(float lo, float hi) { unsigned r; asm volatile("v_cvt_pk_bf16_f32 %0, %1, %2" : "=v"(r) : "v"(lo), "v"(hi)); return r; }
typedef float f32x2 __attribute__((ext_vector_type(2)));
__device__ __forceinline__ f32x2 gelu_pk(f32x2 v) {
    const f32x2 av = __builtin_elementwise_abs(v), d = av * 0.2316418882f + 1.0f;
    f32x2 t; t.x = __builtin_amdgcn_rcpf(d.x); t.y = __builtin_amdgcn_rcpf(d.y);
    f32x2 q = t * 0.5307027145f + (-0.7265760135f); q = q * t + 0.7107068705f; q = q * t + (-0.142248368f); q = q * t + 0.127414796f; q = q * t;
    const f32x2 s = (v * v) * (-0.72134752044f);
    f32x2 e; e.x = __builtin_amdgcn_exp2f(s.x); e.y = __builtin_amdgcn_exp2f(s.y);
    const f32x2 m = v * (q * e), r = v - m;
    f32x2 o; o.x = v.x < 0.f ? m.x : r.x; o.y = v.y < 0.f ? m.y : r.y; return o;
}

template <int ACT  > struct EpiBf16 {
    static constexpr bool PERM = true, AFTER_DRAIN = false; static_assert(ACT == 0 || ACT == 1, "EpiBf16: ACT is 0 (none) or 1 (gelu_pk)");
    bf16_t* O; int ldc; const float* bias; int split_cols; size_t split_stride; float scale0;
    __device__ __forceinline__ void operator()(const f32x4 (&acc)[2][2][4][2], const Unit& u, int wr, int wc, int fr, int fq) const {
        const int row0 = u.pm * BM + wr * 64 + fr; int colt = u.pn * BM; bf16_t* base = O;
        float sc = 1.f; if (split_cols) { const int t = colt / split_cols; base += (size_t)t * split_stride; colt -= t * split_cols; if (t == 0) sc = scale0; }
        const int col0 = colt + wc * 32 + 8 * fq, bcol0 = u.pn * BM + wc * 32 + 8 * fq;
        f32x4 bv[2][2];
#pragma unroll
        for (int bj = 0; bj < 2; ++bj)
#pragma unroll
            for (int n = 0; n < 2; ++n) bv[bj][n] = bias ? *(const f32x4*)(bias + bcol0 + bj * HALF + 4 * n) : (f32x4){0.f, 0.f, 0.f, 0.f};
#pragma unroll
        for (int ai = 0; ai < 2; ++ai)
#pragma unroll
            for (int m = 0; m < 4; ++m) { bf16_t* rowp = base + (size_t)(row0 + ai * HALF + m * 16) * ldc + col0;
#pragma unroll
                for (int bj = 0; bj < 2; ++bj) { f32x4 v0 = acc[ai][bj][m][0] + bv[bj][0], v1 = acc[ai][bj][m][1] + bv[bj][1];
                    if (ACT == 1) { f32x2 a = gelu_pk((f32x2){v0[0], v0[1]}), b = gelu_pk((f32x2){v0[2], v0[3]}), c = gelu_pk((f32x2){v1[0], v1[1]}), d = gelu_pk((f32x2){v1[2], v1[3]});
                        v0 = (f32x4){a.x, a.y, b.x, b.y}; v1 = (f32x4){c.x, c.y, d.x, d.y}; }
                    v0 = v0 * sc; v1 = v1 * sc; u32x4 w; w.x = cvt_pk_bf16(v0[0], v0[1]); w.y = cvt_pk_bf16(v0[2], v0[3]); w.z = cvt_pk_bf16(v1[0], v1[1]); w.w = cvt_pk_bf16(v1[2], v1[3]);
                    *(u32x4*)(rowp + bj * HALF) = w; } }
    }
};

struct EpiResid {
    static constexpr bool PERM = false, AFTER_DRAIN = false;
    const float* base; float* out; const float* gate; int ldc;
    __device__ __forceinline__ void operator()(const f32x4 (&acc)[2][2][4][2], const Unit& u, int wr, int wc, int fr, int fq) const {
        const int row0 = u.pm * BM + wr * 64 + fr, col0 = u.pn * BM + wc * 32 + 4 * fq;
        const float* gb = gate + ((u.pm * BM) >> 12) * 6144 + col0;
        f32x4 gv[2][2];
#pragma unroll
        for (int bj = 0; bj < 2; ++bj)
#pragma unroll
            for (int n = 0; n < 2; ++n) gv[bj][n] = *(const f32x4*)(gb + bj * HALF + n * 16);
#pragma unroll
        for (int ai = 0; ai < 2; ++ai)
#pragma unroll
            for (int m = 0; m < 4; ++m) { const size_t off = (size_t)(row0 + ai * HALF + m * 16) * ldc + col0;
#pragma unroll
                for (int bj = 0; bj < 2; ++bj)
#pragma unroll
                    for (int n = 0; n < 2; ++n) { const f32x4 bs = *(const f32x4*)(base + off + bj * HALF + n * 16); *(f32x4*)(out + off + bj * HALF + n * 16) = bs + gv[bj][n] * acc[ai][bj][m][n]; } }
    }
};
struct EpiSwiglu {
    static constexpr bool PERM = true, AFTER_DRAIN = false;
    bf16_t* O; int ldo;
    __device__ __forceinline__ void operator()(const f32x4 (&acc)[2][2][4][2], const Unit& u, int wr, int wc, int fr, int fq) const {
        const int row0 = u.pm * BM + wr * 64 + fr, hcol0 = u.pn * HALF + wc * 32 + 8 * fq;
#pragma unroll
        for (int ai = 0; ai < 2; ++ai)
#pragma unroll
            for (int m = 0; m < 4; ++m) { bf16_t* rowp = O + (size_t)(row0 + ai * HALF + m * 16) * ldo + hcol0;
                float h[8];
#pragma unroll
                for (int n = 0; n < 2; ++n)
#pragma unroll
                    for (int i = 0; i < 4; ++i) { const float g = acc[ai][0][m][n][i], up = acc[ai][1][m][n][i]; h[4 * n + i] = g * __builtin_amdgcn_rcpf(1.f + __expf(-g)) * up; }
                u32x4 w; w.x = cvt_pk_bf16(h[0], h[1]); w.y = cvt_pk_bf16(h[2], h[3]); w.z = cvt_pk_bf16(h[4], h[5]); w.w = cvt_pk_bf16(h[6], h[7]);
                *(u32x4*)rowp = w; }
    }
};
struct GroupedOrder {
    const int* info; int nM, nN, nwg, G, c;
    __device__ void init(const int* info_, int N, int G_, int c_) { info = info_; nM = __builtin_amdgcn_readfirstlane(info_[0]); nN = N / BM; nwg = nM * nN; G = G_; c = c_; }
    __device__ bool next(int i, Unit& u) const {
        const long L = (long)i * G + c; if (L >= nwg) return false;
        int wgid = (int)L; { const int q = nwg / NXCD, r = nwg % NXCD, xcd = wgid % NXCD, off = wgid / NXCD; wgid = (xcd < r ? xcd * (q + 1) : r * (q + 1) + (xcd - r) * q) + off; }
        const int nig = WGM * nN, gid = wgid / nig, fm = gid * WGM, gsz = (nM - fm) < WGM ? (nM - fm) : WGM;
        u.pm = fm + ((wgid % nig) % gsz); u.pn = (wgid % nig) / gsz; u.bt = __builtin_amdgcn_readfirstlane(info[16 + u.pm]) * nN + u.pn; return true;
    }
    __device__ __forceinline__ void a_ready(const Unit&) const {}
    __device__ __forceinline__ void done(const Unit&) const {}
};

template <class Epi, class Sched, bool ALIGN_EPI = false, bool SP2 = false>
__device__ __forceinline__ void gemm_phase(PG8_LAS unsigned char* lds, const Gemm g, const Sched& S, const Epi& E) {
    const int tid = threadIdx.x, wid = __builtin_amdgcn_readfirstlane(tid >> 6), lane = tid & 63, wr = wid >> 2, wc = wid & 3, fr = lane & 15, fq = lane >> 4;
    const int K = g.K, nt = K / BK;
    unsigned voffA[2], voffB[2];
#pragma unroll
    for (int i = 0; i < 2; ++i) { int R, C; stage_rc(tid * 16 + i * 8192, R, C); const int Rb = Epi::PERM ? ((R & ~31) + perm32(R & 31)) : R;
        voffA[i] = (unsigned)(R * K + C) * 2u; voffB[i] = (unsigned)(Rb * K + C) * 2u; }
    const size_t kstep = (size_t)(BK * 2);
    const size_t hstep = (size_t)HALF * K * 2;
    const size_t tstep = 2 * hstep;
    const unsigned ldsw = (unsigned)wid * 1024u;
    const int aoff = lds_byte(wr * 64 + fr, fq * 8), boff = lds_byte(wc * 32 + fr, fq * 8);
#define PG8_SA(b, h) (((b) * 2 + (h)) * HTB)
#define PG8_SB(b, h) ((4 + (b) * 2 + (h)) * HTB)
#define PG8_STAGE(bufoff, gbase, voff) do { _Pragma("unroll") for (int _i = 0; _i < 2; ++_i) \
        __builtin_amdgcn_global_load_lds((const unsigned*)((const char*)(gbase) + (voff)[_i]), (PG8_LAS unsigned*)(lds + (bufoff) + ldsw + _i * 8192), 16, 0, 0); } while (0)
#define PG8_LDA(dst, b, h) do { _Pragma("unroll") for (int m = 0; m < 4; ++m) _Pragma("unroll") for (int k = 0; k < 2; ++k) dst[m][k] = *(const PG8_LAS bf16x8*)(lds + PG8_SA(b, h) + aoff + m * 2048 + k * 1024); } while (0)
#define PG8_LDB(dst, b, h) do { _Pragma("unroll") for (int n = 0; n < 2; ++n) _Pragma("unroll") for (int k = 0; k < 2; ++k) dst[n][k] = *(const PG8_LAS bf16x8*)(lds + PG8_SB(b, h) + boff + n * 2048 + k * 1024); } while (0)
#define PG8_MMA(ai, bj, At, Bt) do { __builtin_amdgcn_s_setprio(1); _Pragma("unroll") for (int m = 0; m < 4; ++m) _Pragma("unroll") for (int n = 0; n < 2; ++n) _Pragma("unroll") for (int k = 0; k < 2; ++k) \
        acc[ai][bj][m][n] = __builtin_amdgcn_mfma_f32_16x16x32_bf16(Bt[n][k], At[m][k], acc[ai][bj][m][n], 0, 0, 0); __builtin_amdgcn_s_setprio(0); } while (0)
#define PG8_WAIT_V(n) asm volatile("s_waitcnt vmcnt(" #n ")" ::: "memory")
#define PG8_WAIT_L(n) asm volatile("s_waitcnt lgkmcnt(" #n ")" ::: "memory")
#define PG8_BAR __builtin_amdgcn_s_barrier()
#define PG8_SCHED __builtin_amdgcn_sched_barrier(0)
    Unit cur, nxt; int ui = 0;
    if (!S.next(0, cur)) return;
    f32x4 acc[2][2][4][2];
#pragma unroll
    for (int a = 0; a < 2; ++a)
#pragma unroll
        for (int b = 0; b < 2; ++b)
#pragma unroll
            for (int m = 0; m < 4; ++m)
#pragma unroll
                for (int n = 0; n < 2; ++n) acc[a][b][m][n] = (f32x4){0.f, 0.f, 0.f, 0.f};
    bf16x8 At[4][2], B0[2][2], B1[2][2];
    const char* cA = (const char*)g.A + (size_t)cur.pm * tstep; const char* cB = (const char*)g.Bt + (size_t)cur.bt * tstep;
    S.a_ready(cur);
    if constexpr (SP2) {
        PG8_STAGE(PG8_SB(0, 0), cB, voffB); PG8_STAGE(PG8_SB(0, 1), cB + hstep, voffB); PG8_STAGE(PG8_SA(0, 0), cA, voffA); PG8_STAGE(PG8_SA(0, 1), cA + hstep, voffA);
        if (wr == 1) PG8_BAR;
        PG8_WAIT_V(2); PG8_BAR;
        PG8_STAGE(PG8_SB(1, 0), cB + kstep, voffB); PG8_STAGE(PG8_SA(1, 0), cA + kstep, voffA); PG8_STAGE(PG8_SB(1, 1), cB + hstep + kstep, voffB);
        PG8_WAIT_V(6); PG8_BAR;
    } else {
        PG8_STAGE(PG8_SB(0, 0), cB, voffB); PG8_STAGE(PG8_SA(0, 0), cA, voffA); PG8_STAGE(PG8_SB(0, 1), cB + hstep, voffB); PG8_STAGE(PG8_SA(0, 1), cA + hstep, voffA);
        if (wr == 1) PG8_BAR;
        PG8_WAIT_V(4); PG8_BAR;
        PG8_STAGE(PG8_SB(1, 0), cB + kstep, voffB); PG8_STAGE(PG8_SA(1, 0), cA + kstep, voffA); PG8_STAGE(PG8_SB(1, 1), cB + hstep + kstep, voffB);
        PG8_WAIT_V(6); PG8_BAR;
    }
    for (;;) {
        const bool has_next = S.next(ui + 1, nxt);
        const char* nA = has_next ? (const char*)g.A + (size_t)nxt.pm * tstep : cA; const char* nB = has_next ? (const char*)g.Bt + (size_t)nxt.bt * tstep : cB;
        for (int t = 0; t < nt; t += 2) {
            const bool last = (t == nt - 2);
            const char* a1 = cA + (size_t)(t + 1) * kstep;
            const char* a2 = last ? nA : cA + (size_t)(t + 2) * kstep; const char* b2 = last ? nB : cB + (size_t)(t + 2) * kstep;
            const char* a3 = a2 + kstep; const char* b3 = b2 + kstep;
            if (last && has_next) S.a_ready(nxt);
            if constexpr (SP2) {
            PG8_LDB(B0, 0, 0); PG8_LDB(B1, 0, 1); PG8_SCHED; PG8_LDA(At, 0, 0); PG8_STAGE(PG8_SA(1, 1), a1 + hstep, voffA);
            PG8_WAIT_V(8); PG8_WAIT_L(0); PG8_BAR; PG8_MMA(0, 0, At, B0); PG8_MMA(0, 1, At, B1); PG8_BAR; PG8_SCHED;
            PG8_LDA(At, 0, 1); PG8_STAGE(PG8_SB(0, 0), b2, voffB); PG8_STAGE(PG8_SB(0, 1), b2 + hstep, voffB); PG8_STAGE(PG8_SA(0, 0), a2, voffA);
            PG8_WAIT_V(8); PG8_WAIT_L(0); PG8_BAR; PG8_MMA(1, 0, At, B0); PG8_MMA(1, 1, At, B1); PG8_BAR; PG8_SCHED;
            PG8_LDB(B0, 1, 0); PG8_LDB(B1, 1, 1); PG8_SCHED; PG8_LDA(At, 1, 0); PG8_STAGE(PG8_SA(0, 1), a2 + hstep, voffA);
            PG8_WAIT_V(8); PG8_WAIT_L(0); PG8_BAR; PG8_MMA(0, 0, At, B0); PG8_MMA(0, 1, At, B1); PG8_BAR; PG8_SCHED;
            PG8_LDA(At, 1, 1); PG8_STAGE(PG8_SB(1, 0), b3, voffB); PG8_STAGE(PG8_SB(1, 1), b3 + hstep, voffB); PG8_STAGE(PG8_SA(1, 0), a3, voffA);
            PG8_WAIT_V(8); PG8_WAIT_L(0); PG8_BAR; PG8_MMA(1, 0, At, B0); PG8_MMA(1, 1, At, B1); PG8_BAR; PG8_SCHED;
            } else {
            PG8_LDB(B0, 0, 0); PG8_SCHED; PG8_LDA(At, 0, 0); PG8_STAGE(PG8_SA(1, 1), a1 + hstep, voffA);
            PG8_WAIT_L(8); PG8_BAR; PG8_WAIT_L(0); PG8_MMA(0, 0, At, B0); PG8_BAR; PG8_SCHED;
            PG8_LDB(B1, 0, 1); PG8_STAGE(PG8_SB(0, 0), b2, voffB);
            PG8_BAR; PG8_WAIT_L(0); PG8_MMA(0, 1, At, B1); PG8_BAR;
            PG8_LDA(At, 0, 1); PG8_STAGE(PG8_SA(0, 0), a2, voffA);
            PG8_BAR; PG8_WAIT_L(0); PG8_MMA(1, 0, At, B0); PG8_BAR; PG8_SCHED;
            PG8_STAGE(PG8_SB(0, 1), b2 + hstep, voffB);
            PG8_WAIT_V(6); PG8_BAR; PG8_MMA(1, 1, At, B1); PG8_BAR;
            PG8_LDB(B0, 1, 0); PG8_SCHED; PG8_LDA(At, 1, 0); PG8_STAGE(PG8_SA(0, 1), a2 + hstep, voffA);
            PG8_WAIT_L(8); PG8_BAR; PG8_WAIT_L(0); PG8_MMA(0, 0, At, B0); PG8_BAR; PG8_SCHED;
            PG8_LDB(B1, 1, 1); PG8_STAGE(PG8_SB(1, 0), b3, voffB);
            PG8_BAR; PG8_WAIT_L(0); PG8_MMA(0, 1, At, B1); PG8_BAR;
            PG8_LDA(At, 1, 1); PG8_STAGE(PG8_SA(1, 0), a3, voffA);
            PG8_BAR; PG8_WAIT_L(0); PG8_MMA(1, 0, At, B0); PG8_BAR; PG8_SCHED;
            PG8_STAGE(PG8_SB(1, 1), b3 + hstep, voffB);
            PG8_WAIT_V(6); PG8_BAR; PG8_MMA(1, 1, At, B1); PG8_BAR;
            }
        }
        if constexpr (ALIGN_EPI) { if (wr == 0) PG8_BAR; }
        if constexpr (!Epi::AFTER_DRAIN) { E(acc, cur, wr, wc, fr, fq); S.done(cur); }
        if (!has_next) break;
#pragma unroll
        for (int a = 0; a < 2; ++a)
#pragma unroll
            for (int b = 0; b < 2; ++b)
#pragma unroll
                for (int m = 0; m < 4; ++m)
#pragma unroll
                    for (int n = 0; n < 2; ++n) acc[a][b][m][n] = (f32x4){0.f, 0.f, 0.f, 0.f};
        cur = nxt; cA = nA; cB = nB; ++ui;
        if constexpr (ALIGN_EPI) { if (wr == 1) PG8_BAR; }
    }
    PG8_WAIT_V(0);
    if constexpr (!ALIGN_EPI) { if (wr == 0) PG8_BAR; }
    PG8_BAR;
    if constexpr (Epi::AFTER_DRAIN) { E.fused(acc, cur, wr, wc, fr, fq, lds, wid, lane); S.done(cur); }
#undef PG8_SA
#undef PG8_SB
#undef PG8_STAGE
#undef PG8_LDA
#undef PG8_LDB
#undef PG8_MMA
#undef PG8_WAIT_V
#undef PG8_WAIT_L
#undef PG8_BAR
#undef PG8_SCHED
}
}
#define GAS __attribute__((address_space(1)))
#define XB_TMO      128
#define XB_XCNT(j)  (256  + 64 * (j))
#define XB_XSUB(j)  (1280 + 64 * (j))
#define XB_XGEN(j)  (2304 + 64 * (j))
#define XB_TOP      3328
#define XB_TOPGEN   3392
#define XCD_BAR_WORDS 3456
#define XB_SPIN_CAP (1u << 18)

__device__ __forceinline__ unsigned xb_ld(unsigned* p)              { return __hip_atomic_load(p, __ATOMIC_RELAXED, __HIP_MEMORY_SCOPE_AGENT); }
__device__ __forceinline__ unsigned xb_add(unsigned* p, unsigned v) { return __hip_atomic_fetch_add(p, v, __ATOMIC_RELAXED, __HIP_MEMORY_SCOPE_AGENT); }
__device__ __forceinline__ unsigned xb_xcc_id() { return (unsigned)__builtin_amdgcn_s_getreg((3 << 11) | 20) & 0xFu; }
#define XB_SPIN(cond, bar) do { unsigned _sp = 0; while (cond) { __builtin_amdgcn_s_sleep(1); \
    if ((++_sp & 255u) == 0u) { if (xb_ld(&(bar)[XB_TMO])) break; if (_sp > XB_SPIN_CAP) { atomicAdd(&(bar)[XB_TMO], 1u); break; } } } } while (0)

struct XcdBarrier {
    unsigned* bar; unsigned x;
    volatile LAS unsigned* st;
};

__device__ __forceinline__ XcdBarrier xcd_barrier_post(unsigned* bar, volatile LAS unsigned* st) {
    XcdBarrier b; b.bar = bar; b.x = xb_xcc_id(); b.st = st;
    if (threadIdx.x == 0) (void)xb_add(&bar[XB_XCNT(b.x)], 1u);
    return b;
}
__device__ __forceinline__ void xcd_barrier_complete(unsigned* bar, unsigned x, unsigned& nloc, unsigned& nx) {
    const unsigned G = gridDim.x * gridDim.y * gridDim.z;
    unsigned sum, cnt, mine, sp = 0u;
    for (;;) {
        sum = 0u; cnt = 0u; mine = 0u;
#pragma unroll
        for (unsigned j = 0; j < 16; ++j) { const unsigned c = xb_ld(&bar[XB_XCNT(j)]); sum += c; cnt += (c > 0u) ? 1u : 0u; mine = (j == x) ? c : mine; }
        if (sum == G) break;
        __builtin_amdgcn_s_sleep(1);
        if ((++sp & 255u) == 0u) { if (xb_ld(&bar[XB_TMO])) break; if (sp > XB_SPIN_CAP) { atomicAdd(&bar[XB_TMO], 1u); break; } }
    }
    nloc = mine > 0u ? mine : 1u; nx = cnt > 0u ? cnt : 1u;
}

__device__ __forceinline__ void xcd_barrier(const XcdBarrier& b) {
    asm volatile("s_waitcnt vmcnt(0)" ::: "memory");
    __syncthreads();
    if (threadIdx.x == 0) {
        unsigned* bar = b.bar;
        __builtin_amdgcn_s_waitcnt(0);
        unsigned nloc = b.st[0], nx = b.st[1];
        if (nloc == 0u) { xcd_barrier_complete(bar, b.x, nloc, nx); b.st[0] = nloc; b.st[1] = nx; }
        const unsigned old = xb_add(&bar[XB_XSUB(b.x)], 1u);
        const unsigned gen = old / nloc;
        if (old + 1u == (gen + 1u) * nloc) {
            __builtin_amdgcn_fence(__ATOMIC_RELEASE, "agent");
            asm volatile("s_waitcnt vmcnt(0)" ::: "memory");
            const unsigned og = xb_add(&bar[XB_TOP], 1u);
            const unsigned tg = og / nx;
            if (og + 1u == (tg + 1u) * nx) xb_add(&bar[XB_TOPGEN], 1u);
            else XB_SPIN(xb_ld(&bar[XB_TOPGEN]) == tg, bar);
            __builtin_amdgcn_fence(__ATOMIC_ACQUIRE, "agent");
            xb_add(&bar[XB_XGEN(b.x)], 1u);
            asm volatile("s_waitcnt vmcnt(0)" ::: "memory");
        } else {
            XB_SPIN(xb_ld(&bar[XB_XGEN(b.x)]) == gen, bar);
            __builtin_amdgcn_fence(__ATOMIC_ACQUIRE, "agent");
            asm volatile("s_waitcnt vmcnt(0)" ::: "memory");
        }
    }
    __syncthreads();
}

constexpr size_t WT_EIN = WS_WSMALL, WT_EOUT = WT_EIN + 4 * MiB, WT_EUP = WT_EOUT + 2 * MiB, WT_EDN = WT_EUP + 11 * MiB, WT_OIN = WT_EDN + 5 * MiB + 512 * KiB, WT_OOUT = WT_OIN + 6 * MiB;
constexpr size_t WT_MUP = WS_WMOE, WT_MDN = WS_WMOE + 112 * MiB;
static_assert(WT_OOUT + 2 * MiB <= WS_WMOE, "small weights");
__device__ __forceinline__ void cvt_item(const float* W, int K, int N, bf16_t* WT, int dst_row0, int k0, int n0, LAS float* scr, int lane) {
    const int rr = lane >> 3, cc = (lane & 7) * 4;
#pragma unroll
    for (int i = 0; i < 8; ++i) { const int kk = 8 * i + rr; const f32x4 v = *(const f32x4*)(W + (size_t)(k0 + kk) * N + n0 + cc); LAS float* s = scr + kk * 33 + cc; s[0] = v.x; s[1] = v.y; s[2] = v.z; s[3] = v.w; }
    asm volatile("s_waitcnt lgkmcnt(0)" ::: "memory");
    const int c = lane & 7;
#pragma unroll
    for (int j = 0; j < 4; ++j) { const int n = (lane >> 3) + 8 * j; const LAS float* s = scr + (8 * c) * 33 + n;
        u32x4 o; o.x = pk2(s[0 * 33], s[1 * 33]); o.y = pk2(s[2 * 33], s[3 * 33]); o.z = pk2(s[4 * 33], s[5 * 33]); o.w = pk2(s[6 * 33], s[7 * 33]);
        *(u32x4*)(WT + (size_t)(dst_row0 + n) * K + k0 + 8 * c) = o; }
    asm volatile("s_waitcnt lgkmcnt(0)" ::: "memory");
}
__device__ __forceinline__ void cvt_matrix_item(const float* W, int K, int N, bf16_t* WT, int mode, int item, LAS float* scr, int lane) {
    const int nblk = N / 32, kb = item / nblk, nb = item % nblk, n0 = 32 * nb;
    const int dst_row0 = mode == 0 ? n0 : ((n0 >> 7) * 256 + (n0 & 127) + 128 * (mode - 1));
    cvt_item(W, K, N, WT, dst_row0, 64 * kb, n0, scr, lane);
}
__device__ __forceinline__ void stage_convert(const P& p, LAS unsigned char* lds) {
    const int lane = threadIdx.x & 63, wave = __builtin_amdgcn_readfirstlane(threadIdx.x >> 6);
    LAS float* scr = (LAS float*)(lds + wave * 8448);
    const int gw = blockIdx.x * NWAVES + wave, NGW = gridDim.x * NWAVES;
    constexpr int I_EIN = 16 * 64, I_EOUT = 16 * 32, I_EUP = 16 * 88, I_EDN = 44 * 32, I_OIN = 16 * 96, I_OOUT = 16 * 32, I_MUP = 16 * 112, I_MDN = 56 * 32;
    constexpr int NSMALL = I_EIN + I_EOUT + 2 * I_EUP + I_EDN + I_OIN + I_OOUT, NITEMS = NSMALL + 8 * (2 * I_MUP + I_MDN);
    unsigned char* ws = p.ws;
    for (int it = gw; it < NITEMS; it += NGW) {
        int r = it;
        if (r < I_EIN) { cvt_matrix_item(p.in[E_W_IN], 1024, 2048, (bf16_t*)(ws + WT_EIN), 0, r, scr, lane); continue; } r -= I_EIN;
        if (r < I_EOUT) { cvt_matrix_item(p.in[E_W_OUT], 1024, 1024, (bf16_t*)(ws + WT_EOUT), 0, r, scr, lane); continue; } r -= I_EOUT;
        if (r < I_EUP) { cvt_matrix_item(p.in[E_FFN_WG], 1024, FFN, (bf16_t*)(ws + WT_EUP), 1, r, scr, lane); continue; } r -= I_EUP;
        if (r < I_EUP) { cvt_matrix_item(p.in[E_FFN_WU], 1024, FFN, (bf16_t*)(ws + WT_EUP), 2, r, scr, lane); continue; } r -= I_EUP;
        if (r < I_EDN) { cvt_matrix_item(p.in[E_FFN_WD], FFN, 1024, (bf16_t*)(ws + WT_EDN), 0, r, scr, lane); continue; } r -= I_EDN;
        if (r < I_OIN) { cvt_matrix_item(p.in[O_W_IN], 1024, 3072, (bf16_t*)(ws + WT_OIN), 0, r, scr, lane); continue; } r -= I_OIN;
        if (r < I_OOUT) { cvt_matrix_item(p.in[O_W_OUT], 1024, 1024, (bf16_t*)(ws + WT_OOUT), 0, r, scr, lane); continue; } r -= I_OOUT;
        const int e = r / (2 * I_MUP + I_MDN); r -= e * (2 * I_MUP + I_MDN);
        if (r < I_MUP) { cvt_matrix_item(p.in[O_MOE_WG] + (size_t)e * 1024 * ED, 1024, ED, (bf16_t*)(ws + WT_MUP) + (size_t)e * 2 * ED * 1024, 1, r, scr, lane); continue; } r -= I_MUP;
        if (r < I_MUP) { cvt_matrix_item(p.in[O_MOE_WU] + (size_t)e * 1024 * ED, 1024, ED, (bf16_t*)(ws + WT_MUP) + (size_t)e * 2 * ED * 1024, 2, r, scr, lane); continue; } r -= I_MUP;
        cvt_matrix_item(p.in[O_MOE_WD] + (size_t)e * ED * 1024, ED, 1024, (bf16_t*)(ws + WT_MDN) + (size_t)e * 1024 * ED, 0, r, scr, lane);
    }
}

__device__ __forceinline__ void stage_moba_naive(const P& p, LAS unsigned char* lds) {
    const bf16_t* Q = (const bf16_t*)(p.ws + WS_R + R_Q); const bf16_t* K = (const bf16_t*)(p.ws + WS_R + R_K); const bf16_t* V = (const bf16_t*)(p.ws + WS_R + R_V);
    const float* kpart = (const float*)(p.ws + WS_KPART); bf16_t* Y = (bf16_t*)(p.ws + WS_R + R_Y);
    LAS float* km = (LAS float*)lds;
    const int tid = threadIdx.x;
    for (int base = blockIdx.x * 512; base < NB * 8 * SEQ; base += gridDim.x * 512) {
        const int bh = base >> 12, h = bh & 7, b = bh >> 3, sb = base & 4095, own_max = (sb + 511) >> 8;
        for (int i = tid; i < own_max * 64; i += 512) { const int n = i >> 6, d = i & 63; float s = 0.f;
            for (int k = 0; k < 8; ++k) s += kpart[(size_t)(b * 128 + n * 8 + k) * 512 + h * 64 + d];
            km[i] = s * (1.f / 256.f); }
        __syncthreads();
        const int s = sb + tid; const size_t row = (size_t)b * SEQ + s; const int own = s >> 8;
        float q[64];
#pragma unroll
        for (int d = 0; d < 64; ++d) q[d] = bf2f(Q[row * 512 + h * 64 + d]);
        int s0 = -1, s1 = -1, s2 = -1; float g0 = -INFINITY, g1 = -INFINITY, g2 = -INFINITY;
        for (int n = 0; n < own; ++n) { float g = 0.f;
#pragma unroll
            for (int d = 0; d < 64; ++d) g += q[d] * km[n * 64 + d];
            if (g > g0) { g2 = g1; s2 = s1; g1 = g0; s1 = s0; g0 = g; s0 = n; } else if (g > g1) { g2 = g1; s2 = s1; g1 = g; s1 = n; } else if (g > g2) { g2 = g; s2 = n; } }
        float m = -INFINITY, l = 0.f, o[64];
#pragma unroll
        for (int d = 0; d < 64; ++d) o[d] = 0.f;
        for (int pass = 0; pass < 4; ++pass) {
            int blk, nk;
            if (pass == 0) { blk = s0; nk = 256; } else if (pass == 1) { blk = s1; nk = 256; } else if (pass == 2) { blk = s2; nk = 256; } else { blk = own; nk = (s & 255) + 1; }
            if (blk < 0) continue;
            for (int jk = 0; jk < nk; ++jk) { const size_t kr = ((size_t)b * SEQ + blk * 256 + jk) * 512 + h * 64; float sc = 0.f;
#pragma unroll
                for (int d8 = 0; d8 < 8; ++d8) { const u32x4 kv = *(const u32x4*)(K + kr + d8 * 8);
#pragma unroll
                    for (int i = 0; i < 4; ++i) { sc += q[d8 * 8 + 2 * i] * bf2f(kv[i] & 0xffffu); sc += q[d8 * 8 + 2 * i + 1] * bf2f(kv[i] >> 16); } }
                const float mn = fmaxf(m, sc), corr = exp2f(m - mn), pp = exp2f(sc - mn); l = l * corr + pp; m = mn;
#pragma unroll
                for (int d8 = 0; d8 < 8; ++d8) { const u32x4 vv = *(const u32x4*)(V + kr + d8 * 8);
#pragma unroll
                    for (int i = 0; i < 4; ++i) { o[d8 * 8 + 2 * i] = o[d8 * 8 + 2 * i] * corr + pp * bf2f(vv[i] & 0xffffu); o[d8 * 8 + 2 * i + 1] = o[d8 * 8 + 2 * i + 1] * corr + pp * bf2f(vv[i] >> 16); } }
            }
        }
        const float il = 1.f / l;
#pragma unroll
        for (int d8 = 0; d8 < 8; ++d8) { u32x4 w;
#pragma unroll
            for (int i = 0; i < 4; ++i) w[i] = pk2(o[d8 * 8 + 2 * i] * il, o[d8 * 8 + 2 * i + 1] * il);
            *(u32x4*)(Y + row * 1024 + 512 + h * 64 + d8 * 8) = w; }
        __syncthreads();
    }
}

struct Args { const float* in[N_IN]; float* out; unsigned char* ws; int ph_lo, ph_hi; };
constexpr int N_PHASES = 19;
__global__ void __launch_bounds__(NWAVES * 64, 2) mega_fwd(Args args) {
    extern __shared__ __attribute__((aligned(16))) unsigned char lds_raw[];
    LAS unsigned char* lds = (LAS unsigned char*)lds_raw;
    volatile LAS unsigned* MISC = (volatile LAS unsigned*)(lds + MISC_OFF);
    P p; for (int i = 0; i < N_IN; ++i) p.in[i] = args.in[i]; p.out = args.out; p.ws = args.ws;
    const int tid = threadIdx.x, G = gridDim.x;
    for (int u = tid; u < (LDS_BYTES - LDSCTL_OFF) / 4; u += NWAVES * 64) ((LAS unsigned*)(lds + LDSCTL_OFF))[u] = 0u;
    __syncthreads();
    const int lo = args.ph_lo, hi = args.ph_hi;
    const bool use_bar = (hi - lo) > 1;
    unsigned* ctl = (unsigned*)(p.ws + WS_CTL);
    XcdBarrier bar; bar.bar = ctl + CW_BAR; bar.x = 0; bar.st = nullptr;
    if (use_bar) bar = xcd_barrier_post(ctl + CW_BAR, MISC + 8);
#define IN(k) (lo <= (k) && (k) < hi)
#define SEAM(k) do { if (IN(k) && IN((k) + 1)) xcd_barrier(bar); } while (0)
    unsigned char* ws = p.ws;
    bf16_t* XN = (bf16_t*)(ws + WS_R + R_XN); bf16_t* U = (bf16_t*)(ws + WS_R + R_U); bf16_t* Y = (bf16_t*)(ws + WS_R + R_Y); bf16_t* H = (bf16_t*)(ws + WS_R + R_H);
    bf16_t* Xs = (bf16_t*)(ws + WS_XS); bf16_t* Hs = (bf16_t*)(ws + WS_R + R_HS);
    const float* modE = (const float*)(ws + WS_MOD); const float* modO = modE + 4 * 6144;
    const int* info = (const int*)(ws + WS_EXPINFO);
    typedef pg8::EpiBf16<0> EB;

    if (IN(0)) { stage_prep(p, (LAS float*)lds); __syncthreads(); stage_convert(p, lds); } SEAM(0);
    if (IN(1)) stage_norm<false>(p, p.in[I_X], p.in[E_NORM_MIX], modE, 0, 1024, XN); SEAM(1);
    if (IN(2)) { pg8::Gemm g{XN, (const bf16_t*)(ws + WT_EIN), T, 2048, DM}; pg8::StaticOrder S; S.init(T, 2048, G, (int)blockIdx.x);
        EB E{U, 2048, nullptr, 0, 0, 1.f}; pg8::gemm_phase<EB, pg8::StaticOrder, true, true>(lds, g, S, E); } SEAM(2);
    if (IN(3)) stage_griffin_local(p, lds); SEAM(3);
    if (IN(4)) stage_mix0_finish(p, lds); SEAM(4);
    if (IN(5)) { pg8::Gemm g{Y, (const bf16_t*)(ws + WT_EOUT), T, DM, DM}; pg8::StaticOrder S; S.init(T, DM, G, (int)blockIdx.x);
        pg8::EpiResid E{p.in[I_X], p.out, modE + 2048, DM}; pg8::gemm_phase<pg8::EpiResid, pg8::StaticOrder, true, true>(lds, g, S, E); } SEAM(5);
    if (IN(6)) stage_norm<false>(p, p.out, p.in[E_NORM_FFN], modE, 3072, 4096, XN); SEAM(6);
    if (IN(7)) { pg8::Gemm g{XN, (const bf16_t*)(ws + WT_EUP), T, 2 * FFN, DM}; pg8::StaticOrder S; S.init(T, 2 * FFN, G, (int)blockIdx.x);
        pg8::EpiSwiglu E{H, FFN}; pg8::gemm_phase<pg8::EpiSwiglu, pg8::StaticOrder, true, true>(lds, g, S, E); } SEAM(7);
    if (IN(8)) { pg8::Gemm g{H, (const bf16_t*)(ws + WT_EDN), T, DM, FFN}; pg8::StaticOrder S; S.init(T, DM, G, (int)blockIdx.x);
        pg8::EpiResid E{p.out, p.out, modE + 5120, DM}; pg8::gemm_phase<pg8::EpiResid, pg8::StaticOrder, true, true>(lds, g, S, E); } SEAM(8);
    if (IN(9)) stage_norm<false>(p, p.out, p.in[O_NORM_MIX], modO, 0, 1024, XN); SEAM(9);
    if (IN(10)) { pg8::Gemm g{XN, (const bf16_t*)(ws + WT_OIN), T, 3072, DM}; pg8::StaticOrder S; S.init(T, 3072, G, (int)blockIdx.x);
        EB E{U, 3072, nullptr, 0, 0, 1.f}; pg8::gemm_phase<EB, pg8::StaticOrder, true, true>(lds, g, S, E); } SEAM(10);
    if (IN(11)) stage_qkpost(p); SEAM(11);
    if (IN(12)) { stage_shortconv(p); stage_moba_naive(p, lds); } SEAM(12);
    if (IN(13)) { pg8::Gemm g{Y, (const bf16_t*)(ws + WT_OOUT), T, DM, DM}; pg8::StaticOrder S; S.init(T, DM, G, (int)blockIdx.x);
        pg8::EpiResid E{p.out, p.out, modO + 2048, DM}; pg8::gemm_phase<pg8::EpiResid, pg8::StaticOrder, true, true>(lds, g, S, E); } SEAM(13);
    if (IN(14)) stage_norm<true>(p, p.out, p.in[O_NORM_FFN], modO, 3072, 4096, XN); SEAM(14);
    if (IN(15)) stage_route_assign(p, (LAS int*)lds); SEAM(15);
    if (IN(16)) { pg8::Gemm g{Xs, (const bf16_t*)(ws + WT_MUP), MAXROWS, 2 * ED, DM}; pg8::GroupedOrder S; S.init(info, 2 * ED, G, (int)blockIdx.x);
        pg8::EpiSwiglu E{Hs, ED}; pg8::gemm_phase<pg8::EpiSwiglu, pg8::GroupedOrder, true, true>(lds, g, S, E); } SEAM(16);
    if (IN(17)) { pg8::Gemm g{Hs, (const bf16_t*)(ws + WT_MDN), MAXROWS, DM, ED}; pg8::GroupedOrder S; S.init(info, DM, G, (int)blockIdx.x);
        EB E{Xs, DM, nullptr, 0, 0, 1.f}; pg8::gemm_phase<EB, pg8::GroupedOrder, true, true>(lds, g, S, E); } SEAM(17);
    if (IN(18)) stage_combine(p);
#undef IN
#undef SEAM
}

extern "C" void kernel_launch(void* const* d_in, const int* in_sizes, int n_in, void* d_out, int out_size, void* d_ws, size_t ws_size, hipStream_t stream) {
    static int grid = 0;
    if (grid == 0) {
        if (n_in != N_IN || ws_size < WS_END || out_size != T * DM) { fprintf(stderr, "kernel_launch: n_in %d ws %zu (need %zu) out %d\n", n_in, ws_size, (size_t)WS_END, out_size); grid = -1; return; }
        int dev = 0, cus = 0, per_cu = 0;
        if (hipGetDevice(&dev) != hipSuccess || hipDeviceGetAttribute(&cus, hipDeviceAttributeMultiprocessorCount, dev) != hipSuccess) { grid = -1; return; }
        if (hipFuncSetAttribute((const void*)mega_fwd, hipFuncAttributeMaxDynamicSharedMemorySize, LDS_BYTES) != hipSuccess) { fprintf(stderr, "kernel_launch: hipFuncSetAttribute failed\n"); grid = -1; return; }
        if (hipOccupancyMaxActiveBlocksPerMultiprocessor(&per_cu, (const void*)mega_fwd, NWAVES * 64, LDS_BYTES) != hipSuccess || per_cu < 1) { fprintf(stderr, "kernel_launch: occupancy query says %d\n", per_cu); (void)hipGetLastError(); grid = -1; return; }
        grid = cus;
    }
    if (grid < 0) return;
    (void)hipMemsetAsync((char*)d_ws + WS_CTL, 0, CTL_BYTES, stream);
    Args a{};
    for (int i = 0; i < N_IN; ++i) a.in[i] = (const float*)d_in[i];
    a.out = (float*)d_out; a.ws = (unsigned char*)d_ws;
#ifndef MK_PER_PHASE
#define MK_PER_PHASE 1
#endif
    if (MK_PER_PHASE) { for (int k = 0; k < N_PHASES; ++k) { a.ph_lo = k; a.ph_hi = k + 1; hipLaunchKernelGGL(mega_fwd, dim3(grid), dim3(NWAVES * 64), LDS_BYTES, stream, a); } }
    else { a.ph_lo = 0; a.ph_hi = N_PHASES; hipLaunchKernelGGL(mega_fwd, dim3(grid), dim3(NWAVES * 64), LDS_BYTES, stream, a); }
}
```

```cpp
#include <hip/hip_runtime.h>
#include <cstdint>
#include <cstdio>

#define LAS __attribute__((address_space(3)))
typedef unsigned short bf16_t;
typedef short bf16x8 __attribute__((ext_vector_type(8)));
typedef float f32x4 __attribute__((ext_vector_type(4)));
typedef unsigned u32x4 __attribute__((ext_vector_type(4)));
typedef unsigned u32x2 __attribute__((ext_vector_type(2)));

constexpr int NB = 4, SEQ = 4096, DM = 1024, T = NB * SEQ;
constexpr int MIXW = 512, FFN = 2816, NE = 8, ED = 3584;
constexpr int MAXROWS = 34816;
constexpr float C2 = 0.125f * 1.4426950408889634f;

enum In { I_X = 0, I_C, E_ADA_W, E_ADA_B, E_NORM_MIX, E_NORM_FFN, E_W_IN, E_CONV_A_W, E_CONV_A_B, E_LN_A_G, E_LN_A_B, E_CONV_B_W, E_CONV_B_B,
          E_LRU_WA, E_LRU_BA, E_LRU_WX, E_LRU_BX, E_LRU_LAMBDA, E_W_OUT, E_FFN_WG, E_FFN_WU, E_FFN_WD,
          O_ADA_W, O_ADA_B, O_NORM_MIX, O_NORM_FFN, O_W_IN, O_CONV_C_W, O_Q_NORM, O_K_NORM, O_W_OUT, O_ROUTER_W, O_ROUTER_B, O_MOE_WG, O_MOE_WU, O_MOE_WD, N_IN };

constexpr size_t KiB = 1024, MiB = 1024 * 1024;
constexpr size_t WS_CTL = 0, CTL_BYTES = 128 * KiB;
constexpr size_t WS_MOD = 128 * KiB;
constexpr size_t WS_ROPE_C = 320 * KiB, WS_ROPE_S = 832 * KiB;
constexpr size_t WS_AAGG = 1344 * KiB, WS_HAGG = 1856 * KiB;
constexpr size_t WS_KPART = 2368 * KiB;
constexpr size_t WS_TOPE = 3392 * KiB, WS_TOPW = 3520 * KiB, WS_POS = 3648 * KiB;
constexpr size_t WS_EXPINFO = 3776 * KiB;
constexpr size_t WS_KMEAN = 3780 * KiB;
constexpr size_t WS_WSMALL = 4 * MiB;
constexpr size_t WS_WMOE = WS_WSMALL + 30 * MiB + 512 * KiB;
constexpr size_t WS_XS = WS_WMOE + 168 * MiB;
constexpr size_t WS_R = WS_XS + 68 * MiB;
constexpr size_t R_U = 0, R_HLP = 96 * MiB, R_Q = 96 * MiB, R_K = 112 * MiB, R_Y = 128 * MiB, R_XN = 160 * MiB, R_V = 192 * MiB, R_H = 0, R_HS = 0;
constexpr size_t WS_END = WS_R + 238 * MiB;

struct P {
    const float* in[N_IN];
    float* out;
    unsigned char* ws;
};

__device__ __forceinline__ float bf2f(unsigned v) { return __uint_as_float(v << 16); }
__device__ __forceinline__ unsigned f2bf(float f) { unsigned u = __float_as_uint(f); return (u + 0x7fffu + ((u >> 16) & 1u)) >> 16; }
__device__ __forceinline__ unsigned pk2(float lo, float hi) { return f2bf(lo) | (f2bf(hi) << 16); }
__device__ __forceinline__ float wave_sum(float v) {
#pragma unroll
    for (int o = 1; o < 64; o <<= 1) v += __shfl_xor(v, o);
    return v;
}
__device__ __forceinline__ float sigmoidf_(float x) { return 1.f / (1.f + __expf(-x)); }
__device__ __forceinline__ float gelu_tanh(float x) { const float u = 0.7978845608028654f * (x + 0.044715f * x * x * x); return 0.5f * x * (1.f + tanhf(u)); }

__device__ __forceinline__ void stage_prep(const P& p, LAS float* red  ) {
    const int tid = threadIdx.x, lane = tid & 63, wave = tid >> 6;
    float* mod = (float*)(p.ws + WS_MOD);
    for (int chunk = blockIdx.x; chunk < 192; chunk += gridDim.x) {
        const int L = chunk / 96, col0 = (chunk % 96) * 64;
        const float* W = p.in[L ? O_ADA_W : E_ADA_W]; const float* bias = p.in[L ? O_ADA_B : E_ADA_B];
        float acc[4] = {0.f, 0.f, 0.f, 0.f};
        const int k0 = wave * 128;
#pragma unroll 4
        for (int k = k0; k < k0 + 128; ++k) {
            const float w = W[(size_t)k * 6144 + col0 + lane];
#pragma unroll
            for (int b = 0; b < 4; ++b) { const float cv = p.in[I_C][b * 1024 + k]; acc[b] += (cv / (1.f + __expf(-cv))) * w; }
        }
#pragma unroll
        for (int b = 0; b < 4; ++b) red[(wave * 4 + b) * 64 + lane] = acc[b];
        __syncthreads();
        if (tid < 256) { const int b = tid >> 6, l = tid & 63; float s = bias[col0 + l];
#pragma unroll
            for (int w = 0; w < 8; ++w) s += red[(w * 4 + b) * 64 + l];
            mod[(size_t)(L * 4 + b) * 6144 + col0 + l] = s; }
        __syncthreads();
    }
    float* rc = (float*)(p.ws + WS_ROPE_C); float* rs = (float*)(p.ws + WS_ROPE_S);
    for (int i = blockIdx.x * blockDim.x + tid; i < SEQ * 32; i += gridDim.x * blockDim.x) {
        const int pos = i >> 5, d = i & 31;
        const double inv = exp(-(double)d * (1.0 / 32.0) * 9.210340371976184);
        const double ang = (double)pos * inv;
        rc[i] = (float)cos(ang); rs[i] = (float)sin(ang);
    }
}

template <bool ROUTE>
__device__ __forceinline__ void stage_norm(const P& p, const float* X, const float* nw, const float* modL, int sh_off, int sc_off, bf16_t* XN) {
    const int lane = threadIdx.x & 63, wave = threadIdx.x >> 6, nwv = blockDim.x >> 6;
    const int gw = blockIdx.x * nwv + wave, NGW = gridDim.x * nwv;
    f32x4 w4[4];
#pragma unroll
    for (int j = 0; j < 4; ++j) w4[j] = *(const f32x4*)(nw + 4 * lane + 256 * j);
    const float* rw = p.in[O_ROUTER_W]; const float* rb = p.in[O_ROUTER_B];
    int* tope = (int*)(p.ws + WS_TOPE); float* topw = (float*)(p.ws + WS_TOPW);
    for (int row = gw; row < T; row += NGW) {
        const int b = row >> 12;
        const f32x4* xr = (const f32x4*)(X + (size_t)row * DM) + lane;
        f32x4 v[4]; float ss = 0.f;
#pragma unroll
        for (int j = 0; j < 4; ++j) { v[j] = xr[64 * j]; ss += (v[j].x * v[j].x + v[j].y * v[j].y) + (v[j].z * v[j].z + v[j].w * v[j].w); }
        ss = wave_sum(ss);
        const float rstd = 1.0f / sqrtf(ss * (1.f / DM) + 1e-6f);
        const float* sc = modL + b * 6144 + sc_off; const float* sh = modL + b * 6144 + sh_off;
        float lg[8] = {0.f, 0.f, 0.f, 0.f, 0.f, 0.f, 0.f, 0.f};
#pragma unroll
        for (int j = 0; j < 4; ++j) {
            const f32x4 s4 = *(const f32x4*)(sc + 4 * lane + 256 * j), h4 = *(const f32x4*)(sh + 4 * lane + 256 * j);
            const f32x4 o = (v[j] * rstd) * w4[j] * (s4 + 1.f) + h4;
            u32x2 w; w.x = pk2(o.x, o.y); w.y = pk2(o.z, o.w);
            *(u32x2*)(XN + (size_t)row * DM + 4 * lane + 256 * j) = w;
            if (ROUTE) {
#pragma unroll
                for (int i = 0; i < 4; ++i) { const int k = 4 * lane + 256 * j + i; const f32x4 r0 = *(const f32x4*)(rw + k * 8), r1 = *(const f32x4*)(rw + k * 8 + 4);
                    lg[0] += o[i] * r0.x; lg[1] += o[i] * r0.y; lg[2] += o[i] * r0.z; lg[3] += o[i] * r0.w; lg[4] += o[i] * r1.x; lg[5] += o[i] * r1.y; lg[6] += o[i] * r1.z; lg[7] += o[i] * r1.w; }
            }
        }
        if (ROUTE) {
#pragma unroll
            for (int e = 0; e < 8; ++e) lg[e] = wave_sum(lg[e]) + rb[e];
            int e0 = 0; float l0 = lg[0];
#pragma unroll
            for (int e = 1; e < 8; ++e) if (lg[e] > l0) { l0 = lg[e]; e0 = e; }
            int e1 = -1; float l1 = -INFINITY;
#pragma unroll
            for (int e = 0; e < 8; ++e) if (e != e0 && lg[e] > l1) { l1 = lg[e]; e1 = e; }
            const float w0 = 1.f / (1.f + __expf(l1 - l0));
            if (lane == 0) { tope[row * 2] = e0; tope[row * 2 + 1] = e1; topw[row * 2] = w0; topw[row * 2 + 1] = 1.f - w0; }
        }
    }
}

constexpr int GL_WAVE_LDS = 10752;
__device__ __forceinline__ void stage_griffin_local(const P& p, LAS unsigned char* lds) {
    const int tid = threadIdx.x, lane = tid & 63, wave = __builtin_amdgcn_readfirstlane(tid >> 6);
    LAS unsigned char* wl = lds + wave * GL_WAVE_LDS;
    LAS bf16_t* XA = (LAS bf16_t*)wl;
    LAS float* ZA = (LAS float*)(wl + 2304);
    LAS float* ZX = (LAS float*)(wl + 2304 + 4160);
    const int h = wave, c = 64 * h + lane, fr = lane & 15, fq = lane >> 4;
    const float cw0 = p.in[E_CONV_B_W][c], cw1 = p.in[E_CONV_B_W][512 + c], cw2 = p.in[E_CONV_B_W][1024 + c], cw3 = p.in[E_CONV_B_W][1536 + c], cb = p.in[E_CONV_B_B][c];
    const float ba = p.in[E_LRU_BA][c], bx = p.in[E_LRU_BX][c], lam = p.in[E_LRU_LAMBDA][c];
    const float lsl = fminf(lam, 0.f) - log1pf(expf(-fabsf(lam)));
    const float c8 = 8.0f * lsl;
    bf16x8 Ba[2][4], Bx[2][4];
    { const float* wa = p.in[E_LRU_WA] + h * 4096; const float* wx = p.in[E_LRU_WX] + h * 4096;
#pragma unroll
      for (int ks = 0; ks < 2; ++ks)
#pragma unroll
          for (int nt = 0; nt < 4; ++nt)
#pragma unroll
              for (int jj = 0; jj < 8; ++jj) { const int k = 32 * ks + 8 * fq + jj, n = 16 * nt + fr;
                  Ba[ks][nt][jj] = (short)f2bf(wa[k * 64 + n]); Bx[ks][nt][jj] = (short)f2bf(wx[k * 64 + n]); } }
    const bf16_t* U = (const bf16_t*)(p.ws + WS_R + R_U);
    unsigned* HLP = (unsigned*)(p.ws + WS_R + R_HLP);
    float* Aagg = (float*)(p.ws + WS_AAGG); float* Hagg = (float*)(p.ws + WS_HAGG);
    for (int tl = blockIdx.x; tl < 256; tl += gridDim.x) {
        const int b = tl >> 6, j = tl & 63; const size_t row0 = (size_t)b * SEQ + j * 64;
        float x1 = 0.f, x2 = 0.f, x3 = 0.f;
        if (j != 0) { x1 = bf2f(U[(row0 - 1) * 2048 + 1024 + c]); x2 = bf2f(U[(row0 - 2) * 2048 + 1024 + c]); x3 = bf2f(U[(row0 - 3) * 2048 + 1024 + c]); }
        float hst = 0.f, pc = 1.f;
        for (int mt = 0; mt < 4; ++mt) {
            float xb[16];
#pragma unroll
            for (int r = 0; r < 16; ++r) { const float xn = bf2f(U[(row0 + 16 * mt + r) * 2048 + 1024 + c]);
                xb[r] = cb + cw0 * x3 + cw1 * x2 + cw2 * x1 + cw3 * xn; x3 = x2; x2 = x1; x1 = xn; XA[r * 72 + lane] = (bf16_t)f2bf(xb[r]); }
            const bf16x8 a0 = *(const LAS bf16x8*)((LAS unsigned char*)XA + fr * 144 + fq * 16);
            const bf16x8 a1 = *(const LAS bf16x8*)((LAS unsigned char*)XA + fr * 144 + fq * 16 + 64);
#pragma unroll
            for (int nt = 0; nt < 4; ++nt) {
                f32x4 za = {0.f, 0.f, 0.f, 0.f}, zx = {0.f, 0.f, 0.f, 0.f};
                za = __builtin_amdgcn_mfma_f32_16x16x32_bf16(a0, Ba[0][nt], za, 0, 0, 0); za = __builtin_amdgcn_mfma_f32_16x16x32_bf16(a1, Ba[1][nt], za, 0, 0, 0);
                zx = __builtin_amdgcn_mfma_f32_16x16x32_bf16(a0, Bx[0][nt], zx, 0, 0, 0); zx = __builtin_amdgcn_mfma_f32_16x16x32_bf16(a1, Bx[1][nt], zx, 0, 0, 0);
#pragma unroll
                for (int r4 = 0; r4 < 4; ++r4) { ZA[(4 * fq + r4) * 65 + 16 * nt + fr] = za[r4]; ZX[(4 * fq + r4) * 65 + 16 * nt + fr] = zx[r4]; }
            }
#pragma unroll
            for (int r = 0; r < 16; ++r) {
                const float rg = sigmoidf_(ZA[r * 65 + lane] + ba), ig = sigmoidf_(ZX[r * 65 + lane] + bx);
                const float la = c8 * rg, a = __expf(la), mult = sqrtf(-expm1f(2.f * la));
                hst = a * hst + mult * ig * xb[r]; pc *= a;
                HLP[(row0 + 16 * mt + r) * 512 + c] = f2bf(hst) | (f2bf(pc) << 16);
            }
        }
        Aagg[tl * 512 + c] = pc; Hagg[tl * 512 + c] = hst;
    }
}

constexpr int MF_LDS = 95 * 1024;
__device__ __forceinline__ void stage_mix0_finish(const P& p, LAS unsigned char* lds) {
    const int tid = threadIdx.x, lane = tid & 63, wave = __builtin_amdgcn_readfirstlane(tid >> 6);
    const bf16_t* U = (const bf16_t*)(p.ws + WS_R + R_U);
    const unsigned* HLP = (const unsigned*)(p.ws + WS_R + R_HLP);
    const float* Aagg = (const float*)(p.ws + WS_AAGG); const float* Hagg = (const float*)(p.ws + WS_HAGG);
    bf16_t* Y = (bf16_t*)(p.ws + WS_R + R_Y);
    LAS bf16_t* G = (LAS bf16_t*)lds;
    for (int tl = blockIdx.x; tl < 256; tl += gridDim.x) {
        const int b = tl >> 6, j = tl & 63; const size_t row0 = (size_t)b * SEQ + j * 64;
        for (int idx = tid; idx < 95 * 64; idx += 512) {
            const int rho = idx >> 6, ch8 = (idx & 63) * 8, tpos = j * 64 - 30 + rho;
            u32x4 o = {0u, 0u, 0u, 0u};
            if (tpos >= 0 && rho < 94) { const size_t row = (size_t)b * SEQ + tpos;
                const u32x4 av = *(const u32x4*)(U + row * 2048 + ch8), gv = *(const u32x4*)(U + row * 2048 + 512 + ch8);
#pragma unroll
                for (int i = 0; i < 4; ++i) { const float a0 = bf2f(av[i] & 0xffffu), a1 = bf2f(av[i] >> 16), g0 = bf2f(gv[i] & 0xffffu), g1 = bf2f(gv[i] >> 16);
                    o[i] = pk2(a0 * sigmoidf_(g0), a1 * sigmoidf_(g1)); } }
            *(LAS u32x4*)(G + rho * 512 + ch8) = o;
        }
        { const int c = tid; float carry = 0.f;
          for (int jj = 0; jj < j; ++jj) carry = Aagg[(b * 64 + jj) * 512 + c] * carry + Hagg[(b * 64 + jj) * 512 + c];
#pragma unroll 8
          for (int r = 0; r < 64; ++r) { const size_t row = row0 + r; const unsigned hp = HLP[row * 512 + c];
              const float hv = bf2f(hp & 0xffffu) + bf2f(hp >> 16) * carry; const float g = bf2f(U[row * 2048 + 1536 + c]);
              Y[row * 1024 + 512 + c] = (bf16_t)f2bf(hv * gelu_tanh(g)); } }
        __syncthreads();
        f32x4 res[2][8];
#pragma unroll
        for (int ps = 0; ps < 2; ++ps) {
            const int c0 = 256 * ps + 4 * lane;
            const f32x4 bias = *(const f32x4*)(p.in[E_CONV_A_B] + c0);
#pragma unroll
            for (int o = 0; o < 8; ++o) res[ps][o] = bias;
#pragma unroll 1
            for (int jb = 0; jb < 32; jb += 8) {
                f32x4 wv[8], xw[15];
#pragma unroll
                for (int t = 0; t < 8; ++t) { const int jj = jb + t; wv[t] = *(const f32x4*)(p.in[E_CONV_A_W] + (jj < 30 ? jj : 30) * 512 + c0) * (jj <= 30 ? 1.f : 0.f); }
#pragma unroll
                for (int r = 0; r < 15; ++r) { const u32x2 raw = *(const LAS u32x2*)(G + (8 * wave + jb + r) * 512 + c0);
                    xw[r] = (f32x4){bf2f(raw.x & 0xffffu), bf2f(raw.x >> 16), bf2f(raw.y & 0xffffu), bf2f(raw.y >> 16)}; }
#pragma unroll
                for (int o = 0; o < 8; ++o)
#pragma unroll
                    for (int t = 0; t < 8; ++t) res[ps][o] += wv[t] * xw[o + t];
            }
        }
        { const f32x4 g0 = *(const f32x4*)(p.in[E_LN_A_G] + 4 * lane), g1 = *(const f32x4*)(p.in[E_LN_A_G] + 256 + 4 * lane);
          const f32x4 b0 = *(const f32x4*)(p.in[E_LN_A_B] + 4 * lane), b1 = *(const f32x4*)(p.in[E_LN_A_B] + 256 + 4 * lane);
#pragma unroll
          for (int o = 0; o < 8; ++o) {
              float s = (res[0][o].x + res[0][o].y) + (res[0][o].z + res[0][o].w) + (res[1][o].x + res[1][o].y) + (res[1][o].z + res[1][o].w);
              const float mean = wave_sum(s) * (1.f / 512.f);
              const f32x4 d0 = res[0][o] - mean, d1 = res[1][o] - mean;
              float q = (d0.x * d0.x + d0.y * d0.y) + (d0.z * d0.z + d0.w * d0.w) + (d1.x * d1.x + d1.y * d1.y) + (d1.z * d1.z + d1.w * d1.w);
              const float rstd = 1.0f / sqrtf(wave_sum(q) * (1.f / 512.f) + 1e-6f);
              f32x4 y0 = d0 * rstd * g0 + b0, y1 = d1 * rstd * g1 + b1;
              const size_t row = row0 + 8 * wave + o;
              u32x2 w0, w1;
              w0.x = pk2(y0.x * sigmoidf_(y0.x), y0.y * sigmoidf_(y0.y)); w0.y = pk2(y0.z * sigmoidf_(y0.z), y0.w * sigmoidf_(y0.w));
              w1.x = pk2(y1.x * sigmoidf_(y1.x), y1.y * sigmoidf_(y1.y)); w1.y = pk2(y1.z * sigmoidf_(y1.z), y1.w * sigmoidf_(y1.w));
              *(u32x2*)(Y + row * 1024 + 4 * lane) = w0; *(u32x2*)(Y + row * 1024 + 256 + 4 * lane) = w1;
          } }
        __syncthreads();
    }
}

__device__ __forceinline__ void stage_qkpost(const P& p) {
    const int lane = threadIdx.x & 63, wave = threadIdx.x >> 6, nwv = blockDim.x >> 6;
    const int gw = blockIdx.x * nwv + wave, NGW = gridDim.x * nwv;
    const bf16_t* U = (const bf16_t*)(p.ws + WS_R + R_U);
    bf16_t* Q = (bf16_t*)(p.ws + WS_R + R_Q); bf16_t* K = (bf16_t*)(p.ws + WS_R + R_K); bf16_t* V = (bf16_t*)(p.ws + WS_R + R_V);
    float* kpart = (float*)(p.ws + WS_KPART);
    const float* rc = (const float*)(p.ws + WS_ROPE_C); const float* rs = (const float*)(p.ws + WS_ROPE_S);
    const int i8 = lane & 7, dd = 8 * (i8 & 3); const bool hi = i8 >= 4;
    float qn[8], kn[8];
#pragma unroll
    for (int i = 0; i < 8; ++i) { qn[i] = p.in[O_Q_NORM][8 * i8 + i]; kn[i] = p.in[O_K_NORM][8 * i8 + i]; }
    for (int g = gw; g < T / 32; g += NGW) {
        float ksum[8] = {0.f, 0.f, 0.f, 0.f, 0.f, 0.f, 0.f, 0.f};
        for (int r = 0; r < 32; ++r) {
            const size_t row = (size_t)g * 32 + r; const int pos = (int)(row & (SEQ - 1));
            const f32x4 c0 = *(const f32x4*)(rc + pos * 32 + dd), c1 = *(const f32x4*)(rc + pos * 32 + dd + 4);
            const f32x4 s0 = *(const f32x4*)(rs + pos * 32 + dd), s1 = *(const f32x4*)(rs + pos * 32 + dd + 4);
            const float cs[8] = {c0.x, c0.y, c0.z, c0.w, c1.x, c1.y, c1.z, c1.w}, sn[8] = {s0.x, s0.y, s0.z, s0.w, s1.x, s1.y, s1.z, s1.w};
#pragma unroll
            for (int which = 0; which < 2; ++which) {
                const u32x4 raw = *(const u32x4*)(U + row * 3072 + 1536 + 512 * which + 8 * lane);
                float v[8];
#pragma unroll
                for (int i = 0; i < 4; ++i) { v[2 * i] = bf2f(raw[i] & 0xffffu); v[2 * i + 1] = bf2f(raw[i] >> 16); }
                float ss = 0.f;
#pragma unroll
                for (int i = 0; i < 8; ++i) ss += v[i] * v[i];
                ss += __shfl_xor(ss, 1); ss += __shfl_xor(ss, 2); ss += __shfl_xor(ss, 4);
                const float rstd = 1.0f / sqrtf(ss * (1.f / 64.f) + 1e-6f);
                float o[8];
#pragma unroll
                for (int i = 0; i < 8; ++i) { v[i] = v[i] * rstd * (which ? kn[i] : qn[i]); }
#pragma unroll
                for (int i = 0; i < 8; ++i) { const float pv = __shfl_xor(v[i], 4); o[i] = hi ? (v[i] * cs[i] + pv * sn[i]) : (v[i] * cs[i] - pv * sn[i]); }
                u32x4 w;
                if (which == 0) {
#pragma unroll
                    for (int i = 0; i < 4; ++i) w[i] = pk2(o[2 * i] * C2, o[2 * i + 1] * C2);
                    *(u32x4*)(Q + row * 512 + 8 * lane) = w;
                } else {
#pragma unroll
                    for (int i = 0; i < 8; ++i) ksum[i] += o[i];
#pragma unroll
                    for (int i = 0; i < 4; ++i) w[i] = pk2(o[2 * i], o[2 * i + 1]);
                    *(u32x4*)(K + row * 512 + 8 * lane) = w;
                }
            }
            *(u32x4*)(V + row * 512 + 8 * lane) = *(const u32x4*)(U + row * 3072 + 2560 + 8 * lane);
        }
        *(f32x4*)(kpart + (size_t)g * 512 + 8 * lane) = (f32x4){ksum[0], ksum[1], ksum[2], ksum[3]};
        *(f32x4*)(kpart + (size_t)g * 512 + 8 * lane + 4) = (f32x4){ksum[4], ksum[5], ksum[6], ksum[7]};
    }
}

__device__ __forceinline__ void stage_shortconv(const P& p) {
    const bf16_t* U = (const bf16_t*)(p.ws + WS_R + R_U);
    bf16_t* Y = (bf16_t*)(p.ws + WS_R + R_Y);
    const float* cw = p.in[O_CONV_C_W];
    for (int idx = blockIdx.x * blockDim.x + threadIdx.x; idx < T * 64; idx += gridDim.x * blockDim.x) {
        const size_t row = idx >> 6; const int ch8 = (idx & 63) * 8, pos = (int)(row & (SEQ - 1));
        float acc[8] = {0.f, 0.f, 0.f, 0.f, 0.f, 0.f, 0.f, 0.f};
#pragma unroll
        for (int jj = 0; jj < 3; ++jj) {
            if (pos - 2 + jj < 0) continue;
            const size_t r2 = row - 2 + jj;
            const u32x4 hv = *(const u32x4*)(U + r2 * 3072 + ch8), cv = *(const u32x4*)(U + r2 * 3072 + 1024 + ch8);
            const f32x4 wa = *(const f32x4*)(cw + jj * 512 + ch8), wb = *(const f32x4*)(cw + jj * 512 + ch8 + 4);
            const float w[8] = {wa.x, wa.y, wa.z, wa.w, wb.x, wb.y, wb.z, wb.w};
#pragma unroll
            for (int i = 0; i < 4; ++i) { acc[2 * i] += w[2 * i] * (bf2f(hv[i] & 0xffffu) * bf2f(cv[i] & 0xffffu)); acc[2 * i + 1] += w[2 * i + 1] * (bf2f(hv[i] >> 16) * bf2f(cv[i] >> 16)); }
        }
        const u32x4 bv = *(const u32x4*)(U + row * 3072 + 512 + ch8);
        u32x4 o;
#pragma unroll
        for (int i = 0; i < 4; ++i) o[i] = pk2(acc[2 * i] * bf2f(bv[i] & 0xffffu), acc[2 * i + 1] * bf2f(bv[i] >> 16));
        *(u32x4*)(Y + row * 1024 + ch8) = o;
    }
}

__device__ __forceinline__ void stage_route_assign(const P& p, LAS int* li  ) {
    const int tid = threadIdx.x, lane = tid & 63;
    const int* tope = (const int*)(p.ws + WS_TOPE); int* posk = (int*)(p.ws + WS_POS); int* info = (int*)(p.ws + WS_EXPINFO);
    const bf16_t* XN = (const bf16_t*)(p.ws + WS_R + R_XN); bf16_t* Xs = (bf16_t*)(p.ws + WS_XS);
    LAS int* tot = li; LAS int* bef = li + 8; LAS int* base = li + 16; LAS int* lpos = li + 64;
    for (int chunk = blockIdx.x; chunk < 256; chunk += gridDim.x) {
        if (tid < 16) li[tid] = 0;
        __syncthreads();
        int ct[8] = {0, 0, 0, 0, 0, 0, 0, 0}, cb[8] = {0, 0, 0, 0, 0, 0, 0, 0};
        for (int tok = tid; tok < T; tok += 512) {
            const int e0 = tope[tok * 2], e1 = tope[tok * 2 + 1]; const bool before = tok < chunk * 64;
#pragma unroll
            for (int e = 0; e < 8; ++e) {
                ct[e] += __popcll(__ballot(e0 == e)) + __popcll(__ballot(e1 == e));
                cb[e] += __popcll(__ballot(before && e0 == e)) + __popcll(__ballot(before && e1 == e));
            }
        }
        if (lane == 0) {
#pragma unroll
            for (int e = 0; e < 8; ++e) { atomicAdd((int*)&tot[e], ct[e]); atomicAdd((int*)&bef[e], cb[e]); }
        }
        __syncthreads();
        if (tid == 0) {
            int run = 0; int pst[8], pad[8];
#pragma unroll
            for (int e = 0; e < 8; ++e) { pad[e] = (tot[e] + 255) / 256 * 256; pst[e] = run; run += pad[e]; base[e] = pst[e] + bef[e]; }
            if (chunk == 0) { info[0] = run / 256; info[1] = run;
                for (int blk = 0; blk < run / 256; ++blk) { int ee = 7;
#pragma unroll
                    for (int e = 7; e >= 0; --e) if (blk * 256 < pst[e] + pad[e]) ee = e;
                    info[16 + blk] = ee; } }
            for (int t = 0; t < 64; ++t) { const int tok = chunk * 64 + t;
                for (int k = 0; k < 2; ++k) { const int e = tope[tok * 2 + k]; const int ps = base[e]; base[e] = ps + 1; posk[tok * 2 + k] = ps; lpos[t * 2 + k] = ps; } }
        }
        __syncthreads();
        for (int idx = tid; idx < 128 * 128; idx += 512) { const int a = idx >> 7, ch = idx & 127; const int tok = chunk * 64 + (a >> 1); const int ps = lpos[a];
            *(u32x4*)(Xs + (size_t)ps * 1024 + ch * 8) = *(const u32x4*)(XN + (size_t)tok * 1024 + ch * 8); }
        __syncthreads();
    }
}

__device__ __forceinline__ void stage_combine(const P& p) {
    const int lane = threadIdx.x & 63, wave = threadIdx.x >> 6, nwv = blockDim.x >> 6;
    const int gw = blockIdx.x * nwv + wave, NGW = gridDim.x * nwv;
    const int* posk = (const int*)(p.ws + WS_POS); const float* topw = (const float*)(p.ws + WS_TOPW);
    const bf16_t* Ys = (const bf16_t*)(p.ws + WS_XS); const float* modO = (const float*)(p.ws + WS_MOD) + 4 * 6144;
    for (int row = gw; row < T; row += NGW) {
        const int b = row >> 12; const int p0 = posk[row * 2], p1 = posk[row * 2 + 1]; const float w0 = topw[row * 2], w1 = topw[row * 2 + 1];
#pragma unroll
        for (int j = 0; j < 4; ++j) { const int col = 4 * lane + 256 * j;
            const u32x2 a = *(const u32x2*)(Ys + (size_t)p0 * 1024 + col), c = *(const u32x2*)(Ys + (size_t)p1 * 1024 + col);
            const f32x4 g = *(const f32x4*)(modO + b * 6144 + 5120 + col);
            f32x4 x = *(const f32x4*)(p.out + (size_t)row * DM + col);
            f32x4 m; m.x = w0 * bf2f(a.x & 0xffffu) + w1 * bf2f(c.x & 0xffffu); m.y = w0 * bf2f(a.x >> 16) + w1 * bf2f(c.x >> 16);
            m.z = w0 * bf2f(a.y & 0xffffu) + w1 * bf2f(c.y & 0xffffu); m.w = w0 * bf2f(a.y >> 16) + w1 * bf2f(c.y >> 16);
            *(f32x4*)(p.out + (size_t)row * DM + col) = x + g * m; }
    }
}


constexpr int NWAVES = 8;
constexpr int RING_BYTES = 131072, LDSCTL_OFF = RING_BYTES, MISC_OFF = LDSCTL_OFF + 320, LDS_BYTES = 147456;
constexpr int CW_BAR = 1024;
typedef __attribute__((address_space(1))) unsigned gu32;
#define RLX_AGENT __ATOMIC_RELAXED, __HIP_MEMORY_SCOPE_AGENT
namespace pg8 {
#define PG8_LAS __attribute__((address_space(3)))
typedef unsigned short bf16_t;
typedef short bf16x8 __attribute__((ext_vector_type(8)));
typedef float f32x4 __attribute__((ext_vector_type(4)));
typedef unsigned u32x4 __attribute__((ext_vector_type(4)));
constexpr int BM = 256, BK = 64, HALF = 128, HTB = HALF * BK * 2  , STAGE_BYTES = 8 * HTB, NXCD = 8, WGM = 8;

__host__ __device__ __forceinline__ int lds_byte(int r, int c) { const int st = (r >> 4) * 2 + (c >> 5), rr = r & 15, cc = c & 31, ob = rr * 64 + cc * 2; return st * 1024 + (ob ^ (((ob >> 9) & 1) << 5)); }
__host__ __device__ __forceinline__ void stage_rc(int b, int& R, int& C) { const int st = b / 1024, sb = b % 1024, swz = sb ^ (((sb >> 9) & 1) << 5); R = (st >> 1) * 16 + swz / 64; C = (st & 1) * 32 + (swz % 64) / 2; }
__host__ __device__ __forceinline__ int perm32(int rho) { const int n = rho >> 4, i = rho & 15; return 8 * (i >> 2) + 4 * n + (i & 3); }

struct Unit { int pm, pn, bt; };
struct Gemm { const bf16_t* A; const bf16_t* Bt; int M, N, K; };

struct StaticOrder {
    int nM, nN, nwg, G, c;
    __host__ __device__ void init(int M, int N, int G_, int c_) { nM = M / BM; nN = N / BM; nwg = nM * nN; G = G_; c = c_; }
    __host__ __device__ bool next(int i, Unit& u) const {
        const long L = (long)i * G + c; if (L >= nwg) return false;
        int wgid = (int)L; { const int q = nwg / NXCD, r = nwg % NXCD, xcd = wgid % NXCD, off = wgid / NXCD; wgid = (xcd < r ? xcd * (q + 1) : r * (q + 1) + (xcd - r) * q) + off; }
        const int nig = WGM * nN, gid = wgid / nig, fm = gid * WGM, gsz = (nM - fm) < WGM ? (nM - fm) : WGM;
        u.pm = fm + ((wgid % nig) % gsz); u.pn = (wgid % nig) / gsz; u.bt = u.pn; return true;
    }
    __device__ __forceinline__ void a_ready(const Unit&) const {}
    __device__ __forceinline__ void done(const Unit&) const {}
};

__device__ __forceinline__ unsigned cvt_pk_bf16(float lo, float hi) { unsigned r; asm volatile("v_cvt_pk_bf16_f32 %0, %1, %2" : "=v"(r) : "v"(lo), "v"(hi)); return r; }
typedef float f32x2 __attribute__((ext_vector_type(2)));
__device__ __forceinline__ f32x2 gelu_pk(f32x2 v) {
    const f32x2 av = __builtin_elementwise_abs(v), d = av * 0.2316418882f + 1.0f;
    f32x2 t; t.x = __builtin_amdgcn_rcpf(d.x); t.y = __builtin_amdgcn_rcpf(d.y);
    f32x2 q = t * 0.5307027145f + (-0.7265760135f); q = q * t + 0.7107068705f; q = q * t + (-0.142248368f); q = q * t + 0.127414796f; q = q * t;
    const f32x2 s = (v * v) * (-0.72134752044f);
    f32x2 e; e.x = __builtin_amdgcn_exp2f(s.x); e.y = __builtin_amdgcn_exp2f(s.y);
    const f32x2 m = v * (q * e), r = v - m;
    f32x2 o; o.x = v.x < 0.f ? m.x : r.x; o.y = v.y < 0.f ? m.y : r.y; return o;
}

template <int ACT  > struct EpiBf16 {
    static constexpr bool PERM = true, AFTER_DRAIN = false; static_assert(ACT == 0 || ACT == 1, "EpiBf16: ACT is 0 (none) or 1 (gelu_pk)");
    bf16_t* O; int ldc; const float* bias; int split_cols; size_t split_stride; float scale0;
    __device__ __forceinline__ void operator()(const f32x4 (&acc)[2][2][4][2], const Unit& u, int wr, int wc, int fr, int fq) const {
        const int row0 = u.pm * BM + wr * 64 + fr; int colt = u.pn * BM; bf16_t* base = O;
        float sc = 1.f; if (split_cols) { const int t = colt / split_cols; base += (size_t)t * split_stride; colt -= t * split_cols; if (t == 0) sc = scale0; }
        const int col0 = colt + wc * 32 + 8 * fq, bcol0 = u.pn * BM + wc * 32 + 8 * fq;
        f32x4 bv[2][2];
#pragma unroll
        for (int bj = 0; bj < 2; ++bj)
#pragma unroll
            for (int n = 0; n < 2; ++n) bv[bj][n] = bias ? *(const f32x4*)(bias + bcol0 + bj * HALF + 4 * n) : (f32x4){0.f, 0.f, 0.f, 0.f};
#pragma unroll
        for (int ai = 0; ai < 2; ++ai)
#pragma unroll
            for (int m = 0; m < 4; ++m) { bf16_t* rowp = base + (size_t)(row0 + ai * HALF + m * 16) * ldc + col0;
#pragma unroll
                for (int bj = 0; bj < 2; ++bj) { f32x4 v0 = acc[ai][bj][m][0] + bv[bj][0], v1 = acc[ai][bj][m][1] + bv[bj][1];
                    if (ACT == 1) { f32x2 a = gelu_pk((f32x2){v0[0], v0[1]}), b = gelu_pk((f32x2){v0[2], v0[3]}), c = gelu_pk((f32x2){v1[0], v1[1]}), d = gelu_pk((f32x2){v1[2], v1[3]});
                        v0 = (f32x4){a.x, a.y, b.x, b.y}; v1 = (f32x4){c.x, c.y, d.x, d.y}; }
                    v0 = v0 * sc; v1 = v1 * sc; u32x4 w; w.x = cvt_pk_bf16(v0[0], v0[1]); w.y = cvt_pk_bf16(v0[2], v0[3]); w.z = cvt_pk_bf16(v1[0], v1[1]); w.w = cvt_pk_bf16(v1[2], v1[3]);
                    *(u32x4*)(rowp + bj * HALF) = w; } }
    }
};

struct EpiResid {
    static constexpr bool PERM = false, AFTER_DRAIN = false;
    const float* base; float* out; const float* gate; int ldc;
    __device__ __forceinline__ void operator()(const f32x4 (&acc)[2][2][4][2], const Unit& u, int wr, int wc, int fr, int fq) const {
        const int row0 = u.pm * BM + wr * 64 + fr, col0 = u.pn * BM + wc * 32 + 4 * fq;
        const float* gb = gate + ((u.pm * BM) >> 12) * 6144 + col0;
        f32x4 gv[2][2];
#pragma unroll
        for (int bj = 0; bj < 2; ++bj)
#pragma unroll
            for (int n = 0; n < 2; ++n) gv[bj][n] = *(const f32x4*)(gb + bj * HALF + n * 16);
#pragma unroll
        for (int ai = 0; ai < 2; ++ai)
#pragma unroll
            for (int m = 0; m < 4; ++m) { const size_t off = (size_t)(row0 + ai * HALF + m * 16) * ldc + col0;
#pragma unroll
                for (int bj = 0; bj < 2; ++bj)
#pragma unroll
                    for (int n = 0; n < 2; ++n) { const f32x4 bs = *(const f32x4*)(base + off + bj * HALF + n * 16); *(f32x4*)(out + off + bj * HALF + n * 16) = bs + gv[bj][n] * acc[ai][bj][m][n]; } }
    }
};
struct EpiSwiglu {
    static constexpr bool PERM = true, AFTER_DRAIN = false;
    bf16_t* O; int ldo;
    __device__ __forceinline__ void operator()(const f32x4 (&acc)[2][2][4][2], const Unit& u, int wr, int wc, int fr, int fq) const {
        const int row0 = u.pm * BM + wr * 64 + fr, hcol0 = u.pn * HALF + wc * 32 + 8 * fq;
#pragma unroll
        for (int ai = 0; ai < 2; ++ai)
#pragma unroll
            for (int m = 0; m < 4; ++m) { bf16_t* rowp = O + (size_t)(row0 + ai * HALF + m * 16) * ldo + hcol0;
                float h[8];
#pragma unroll
                for (int n = 0; n < 2; ++n)
#pragma unroll
                    for (int i = 0; i < 4; ++i) { const float g = acc[ai][0][m][n][i], up = acc[ai][1][m][n][i]; h[4 * n + i] = g * __builtin_amdgcn_rcpf(1.f + __expf(-g)) * up; }
                u32x4 w; w.x = cvt_pk_bf16(h[0], h[1]); w.y = cvt_pk_bf16(h[2], h[3]); w.z = cvt_pk_bf16(h[4], h[5]); w.w = cvt_pk_bf16(h[6], h[7]);
                *(u32x4*)rowp = w; }
    }
};
struct GroupedOrder {
    const int* info; int nM, nN, nwg, G, c;
    __device__ void init(const int* info_, int N, int G_, int c_) { info = info_; nM = __builtin_amdgcn_readfirstlane(info_[0]); nN = N / BM; nwg = nM * nN; G = G_; c = c_; }
    __device__ bool next(int i, Unit& u) const {
        const long L = (long)i * G + c; if (L >= nwg) return false;
        int wgid = (int)L; { const int q = nwg / NXCD, r = nwg % NXCD, xcd = wgid % NXCD, off = wgid / NXCD; wgid = (xcd < r ? xcd * (q + 1) : r * (q + 1) + (xcd - r) * q) + off; }
        const int nig = WGM * nN, gid = wgid / nig, fm = gid * WGM, gsz = (nM - fm) < WGM ? (nM - fm) : WGM;
        u.pm = fm + ((wgid % nig) % gsz); u.pn = (wgid % nig) / gsz; u.bt = __builtin_amdgcn_readfirstlane(info[16 + u.pm]) * nN + u.pn; return true;
    }
    __device__ __forceinline__ void a_ready(const Unit&) const {}
    __device__ __forceinline__ void done(const Unit&) const {}
};

template <class Epi, class Sched, bool ALIGN_EPI = false, bool SP2 = false>
__device__ __forceinline__ void gemm_phase(PG8_LAS unsigned char* lds, const Gemm g, const Sched& S, const Epi& E) {
    const int tid = threadIdx.x, wid = __builtin_amdgcn_readfirstlane(tid >> 6), lane = tid & 63, wr = wid >> 2, wc = wid & 3, fr = lane & 15, fq = lane >> 4;
    const int K = g.K, nt = K / BK;
    unsigned voffA[2], voffB[2];
#pragma unroll
    for (int i = 0; i < 2; ++i) { int R, C; stage_rc(tid * 16 + i * 8192, R, C); const int Rb = Epi::PERM ? ((R & ~31) + perm32(R & 31)) : R;
        voffA[i] = (unsigned)(R * K + C) * 2u; voffB[i] = (unsigned)(Rb * K + C) * 2u; }
    const size_t kstep = (size_t)(BK * 2);
    const size_t hstep = (size_t)HALF * K * 2;
    const size_t tstep = 2 * hstep;
    const unsigned ldsw = (unsigned)wid * 1024u;
    const int aoff = lds_byte(wr * 64 + fr, fq * 8), boff = lds_byte(wc * 32 + fr, fq * 8);
#define PG8_SA(b, h) (((b) * 2 + (h)) * HTB)
#define PG8_SB(b, h) ((4 + (b) * 2 + (h)) * HTB)
#define PG8_STAGE(bufoff, gbase, voff) do { _Pragma("unroll") for (int _i = 0; _i < 2; ++_i) \
        __builtin_amdgcn_global_load_lds((const unsigned*)((const char*)(gbase) + (voff)[_i]), (PG8_LAS unsigned*)(lds + (bufoff) + ldsw + _i * 8192), 16, 0, 0); } while (0)
#define PG8_LDA(dst, b, h) do { _Pragma("unroll") for (int m = 0; m < 4; ++m) _Pragma("unroll") for (int k = 0; k < 2; ++k) dst[m][k] = *(const PG8_LAS bf16x8*)(lds + PG8_SA(b, h) + aoff + m * 2048 + k * 1024); } while (0)
#define PG8_LDB(dst, b, h) do { _Pragma("unroll") for (int n = 0; n < 2; ++n) _Pragma("unroll") for (int k = 0; k < 2; ++k) dst[n][k] = *(const PG8_LAS bf16x8*)(lds + PG8_SB(b, h) + boff + n * 2048 + k * 1024); } while (0)
#define PG8_MMA(ai, bj, At, Bt) do { __builtin_amdgcn_s_setprio(1); _Pragma("unroll") for (int m = 0; m < 4; ++m) _Pragma("unroll") for (int n = 0; n < 2; ++n) _Pragma("unroll") for (int k = 0; k < 2; ++k) \
        acc[ai][bj][m][n] = __builtin_amdgcn_mfma_f32_16x16x32_bf16(Bt[n][k], At[m][k], acc[ai][bj][m][n], 0, 0, 0); __builtin_amdgcn_s_setprio(0); } while (0)
#define PG8_WAIT_V(n) asm volatile("s_waitcnt vmcnt(" #n ")" ::: "memory")
#define PG8_WAIT_L(n) asm volatile("s_waitcnt lgkmcnt(" #n ")" ::: "memory")
#define PG8_BAR __builtin_amdgcn_s_barrier()
#define PG8_SCHED __builtin_amdgcn_sched_barrier(0)
    Unit cur, nxt; int ui = 0;
    if (!S.next(0, cur)) return;
    f32x4 acc[2][2][4][2];
#pragma unroll
    for (int a = 0; a < 2; ++a)
#pragma unroll
        for (int b = 0; b < 2; ++b)
#pragma unroll
            for (int m = 0; m < 4; ++m)
#pragma unroll
                for (int n = 0; n < 2; ++n) acc[a][b][m][n] = (f32x4){0.f, 0.f, 0.f, 0.f};
    bf16x8 At[4][2], B0[2][2], B1[2][2];
    const char* cA = (const char*)g.A + (size_t)cur.pm * tstep; const char* cB = (const char*)g.Bt + (size_t)cur.bt * tstep;
    S.a_ready(cur);
    if constexpr (SP2) {
        PG8_STAGE(PG8_SB(0, 0), cB, voffB); PG8_STAGE(PG8_SB(0, 1), cB + hstep, voffB); PG8_STAGE(PG8_SA(0, 0), cA, voffA); PG8_STAGE(PG8_SA(0, 1), cA + hstep, voffA);
        if (wr == 1) PG8_BAR;
        PG8_WAIT_V(2); PG8_BAR;
        PG8_STAGE(PG8_SB(1, 0), cB + kstep, voffB); PG8_STAGE(PG8_SA(1, 0), cA + kstep, voffA); PG8_STAGE(PG8_SB(1, 1), cB + hstep + kstep, voffB);
        PG8_WAIT_V(6); PG8_BAR;
    } else {
        PG8_STAGE(PG8_SB(0, 0), cB, voffB); PG8_STAGE(PG8_SA(0, 0), cA, voffA); PG8_STAGE(PG8_SB(0, 1), cB + hstep, voffB); PG8_STAGE(PG8_SA(0, 1), cA + hstep, voffA);
        if (wr == 1) PG8_BAR;
        PG8_WAIT_V(4); PG8_BAR;
        PG8_STAGE(PG8_SB(1, 0), cB + kstep, voffB); PG8_STAGE(PG8_SA(1, 0), cA + kstep, voffA); PG8_STAGE(PG8_SB(1, 1), cB + hstep + kstep, voffB);
        PG8_WAIT_V(6); PG8_BAR;
    }
    for (;;) {
        const bool has_next = S.next(ui + 1, nxt);
        const char* nA = has_next ? (const char*)g.A + (size_t)nxt.pm * tstep : cA; const char* nB = has_next ? (const char*)g.Bt + (size_t)nxt.bt * tstep : cB;
        for (int t = 0; t < nt; t += 2) {
            const bool last = (t == nt - 2);
            const char* a1 = cA + (size_t)(t + 1) * kstep;
            const char* a2 = last ? nA : cA + (size_t)(t + 2) * kstep; const char* b2 = last ? nB : cB + (size_t)(t + 2) * kstep;
            const char* a3 = a2 + kstep; const char* b3 = b2 + kstep;
            if (last && has_next) S.a_ready(nxt);
            if constexpr (SP2) {
            PG8_LDB(B0, 0, 0); PG8_LDB(B1, 0, 1); PG8_SCHED; PG8_LDA(At, 0, 0); PG8_STAGE(PG8_SA(1, 1), a1 + hstep, voffA);
            PG8_WAIT_V(8); PG8_WAIT_L(0); PG8_BAR; PG8_MMA(0, 0, At, B0); PG8_MMA(0, 1, At, B1); PG8_BAR; PG8_SCHED;
            PG8_LDA(At, 0, 1); PG8_STAGE(PG8_SB(0, 0), b2, voffB); PG8_STAGE(PG8_SB(0, 1), b2 + hstep, voffB); PG8_STAGE(PG8_SA(0, 0), a2, voffA);
            PG8_WAIT_V(8); PG8_WAIT_L(0); PG8_BAR; PG8_MMA(1, 0, At, B0); PG8_MMA(1, 1, At, B1); PG8_BAR; PG8_SCHED;
            PG8_LDB(B0, 1, 0); PG8_LDB(B1, 1, 1); PG8_SCHED; PG8_LDA(At, 1, 0); PG8_STAGE(PG8_SA(0, 1), a2 + hstep, voffA);
            PG8_WAIT_V(8); PG8_WAIT_L(0); PG8_BAR; PG8_MMA(0, 0, At, B0); PG8_MMA(0, 1, At, B1); PG8_BAR; PG8_SCHED;
            PG8_LDA(At, 1, 1); PG8_STAGE(PG8_SB(1, 0), b3, voffB); PG8_STAGE(PG8_SB(1, 1), b3 + hstep, voffB); PG8_STAGE(PG8_SA(1, 0), a3, voffA);
            PG8_WAIT_V(8); PG8_WAIT_L(0); PG8_BAR; PG8_MMA(1, 0, At, B0); PG8_MMA(1, 1, At, B1); PG8_BAR; PG8_SCHED;
            } else {
            PG8_LDB(B0, 0, 0); PG8_SCHED; PG8_LDA(At, 0, 0); PG8_STAGE(PG8_SA(1, 1), a1 + hstep, voffA);
            PG8_WAIT_L(8); PG8_BAR; PG8_WAIT_L(0); PG8_MMA(0, 0, At, B0); PG8_BAR; PG8_SCHED;
            PG8_LDB(B1, 0, 1); PG8_STAGE(PG8_SB(0, 0), b2, voffB);
            PG8_BAR; PG8_WAIT_L(0); PG8_MMA(0, 1, At, B1); PG8_BAR;
            PG8_LDA(At, 0, 1); PG8_STAGE(PG8_SA(0, 0), a2, voffA);
            PG8_BAR; PG8_WAIT_L(0); PG8_MMA(1, 0, At, B0); PG8_BAR; PG8_SCHED;
            PG8_STAGE(PG8_SB(0, 1), b2 + hstep, voffB);
            PG8_WAIT_V(6); PG8_BAR; PG8_MMA(1, 1, At, B1); PG8_BAR;
            PG8_LDB(B0, 1, 0); PG8_SCHED; PG8_LDA(At, 1, 0); PG8_STAGE(PG8_SA(0, 1), a2 + hstep, voffA);
            PG8_WAIT_L(8); PG8_BAR; PG8_WAIT_L(0); PG8_MMA(0, 0, At, B0); PG8_BAR; PG8_SCHED;
            PG8_LDB(B1, 1, 1); PG8_STAGE(PG8_SB(1, 0), b3, voffB);
            PG8_BAR; PG8_WAIT_L(0); PG8_MMA(0, 1, At, B1); PG8_BAR;
            PG8_LDA(At, 1, 1); PG8_STAGE(PG8_SA(1, 0), a3, voffA);
            PG8_BAR; PG8_WAIT_L(0); PG8_MMA(1, 0, At, B0); PG8_BAR; PG8_SCHED;
            PG8_STAGE(PG8_SB(1, 1), b3 + hstep, voffB);
            PG8_WAIT_V(6); PG8_BAR; PG8_MMA(1, 1, At, B1); PG8_BAR;
            }
        }
        if constexpr (ALIGN_EPI) { if (wr == 0) PG8_BAR; }
        if constexpr (!Epi::AFTER_DRAIN) { E(acc, cur, wr, wc, fr, fq); S.done(cur); }
        if (!has_next) break;
#pragma unroll
        for (int a = 0; a < 2; ++a)
#pragma unroll
            for (int b = 0; b < 2; ++b)
#pragma unroll
                for (int m = 0; m < 4; ++m)
#pragma unroll
                    for (int n = 0; n < 2; ++n) acc[a][b][m][n] = (f32x4){0.f, 0.f, 0.f, 0.f};
        cur = nxt; cA = nA; cB = nB; ++ui;
        if constexpr (ALIGN_EPI) { if (wr == 1) PG8_BAR; }
    }
    PG8_WAIT_V(0);
    if constexpr (!ALIGN_EPI) { if (wr == 0) PG8_BAR; }
    PG8_BAR;
    if constexpr (Epi::AFTER_DRAIN) { E.fused(acc, cur, wr, wc, fr, fq, lds, wid, lane); S.done(cur); }
#undef PG8_SA
#undef PG8_SB
#undef PG8_STAGE
#undef PG8_LDA
#undef PG8_LDB
#undef PG8_MMA
#undef PG8_WAIT_V
#undef PG8_WAIT_L
#undef PG8_BAR
#undef PG8_SCHED
}
}
#define GAS __attribute__((address_space(1)))
#define XB_TMO      128
#define XB_XCNT(j)  (256  + 64 * (j))
#define XB_XSUB(j)  (1280 + 64 * (j))
#define XB_XGEN(j)  (2304 + 64 * (j))
#define XB_TOP      3328
#define XB_TOPGEN   3392
#define XCD_BAR_WORDS 3456
#define XB_SPIN_CAP (1u << 18)

__device__ __forceinline__ unsigned xb_ld(unsigned* p)              { return __hip_atomic_load(p, __ATOMIC_RELAXED, __HIP_MEMORY_SCOPE_AGENT); }
__device__ __forceinline__ unsigned xb_add(unsigned* p, unsigned v) { return __hip_atomic_fetch_add(p, v, __ATOMIC_RELAXED, __HIP_MEMORY_SCOPE_AGENT); }
__device__ __forceinline__ unsigned xb_xcc_id() { return (unsigned)__builtin_amdgcn_s_getreg((3 << 11) | 20) & 0xFu; }
#define XB_SPIN(cond, bar) do { unsigned _sp = 0; while (cond) { __builtin_amdgcn_s_sleep(1); \
    if ((++_sp & 255u) == 0u) { if (xb_ld(&(bar)[XB_TMO])) break; if (_sp > XB_SPIN_CAP) { atomicAdd(&(bar)[XB_TMO], 1u); break; } } } } while (0)

struct XcdBarrier {
    unsigned* bar; unsigned x;
    volatile LAS unsigned* st;
};

__device__ __forceinline__ XcdBarrier xcd_barrier_post(unsigned* bar, volatile LAS unsigned* st) {
    XcdBarrier b; b.bar = bar; b.x = xb_xcc_id(); b.st = st;
    if (threadIdx.x == 0) (void)xb_add(&bar[XB_XCNT(b.x)], 1u);
    return b;
}
__device__ __forceinline__ void xcd_barrier_complete(unsigned* bar, unsigned x, unsigned& nloc, unsigned& nx) {
    const unsigned G = gridDim.x * gridDim.y * gridDim.z;
    unsigned sum, cnt, mine, sp = 0u;
    for (;;) {
        sum = 0u; cnt = 0u; mine = 0u;
#pragma unroll
        for (unsigned j = 0; j < 16; ++j) { const unsigned c = xb_ld(&bar[XB_XCNT(j)]); sum += c; cnt += (c > 0u) ? 1u : 0u; mine = (j == x) ? c : mine; }
        if (sum == G) break;
        __builtin_amdgcn_s_sleep(1);
        if ((++sp & 255u) == 0u) { if (xb_ld(&bar[XB_TMO])) break; if (sp > XB_SPIN_CAP) { atomicAdd(&bar[XB_TMO], 1u); break; } }
    }
    nloc = mine > 0u ? mine : 1u; nx = cnt > 0u ? cnt : 1u;
}

__device__ __forceinline__ void xcd_barrier(const XcdBarrier& b) {
    asm volatile("s_waitcnt vmcnt(0)" ::: "memory");
    __syncthreads();
    if (threadIdx.x == 0) {
        unsigned* bar = b.bar;
        __builtin_amdgcn_s_waitcnt(0);
        unsigned nloc = b.st[0], nx = b.st[1];
        if (nloc == 0u) { xcd_barrier_complete(bar, b.x, nloc, nx); b.st[0] = nloc; b.st[1] = nx; }
        const unsigned old = xb_add(&bar[XB_XSUB(b.x)], 1u);
        const unsigned gen = old / nloc;
        if (old + 1u == (gen + 1u) * nloc) {
            __builtin_amdgcn_fence(__ATOMIC_RELEASE, "agent");
            asm volatile("s_waitcnt vmcnt(0)" ::: "memory");
            const unsigned og = xb_add(&bar[XB_TOP], 1u);
            const unsigned tg = og / nx;
            if (og + 1u == (tg + 1u) * nx) xb_add(&bar[XB_TOPGEN], 1u);
            else XB_SPIN(xb_ld(&bar[XB_TOPGEN]) == tg, bar);
            __builtin_amdgcn_fence(__ATOMIC_ACQUIRE, "agent");
            xb_add(&bar[XB_XGEN(b.x)], 1u);
            asm volatile("s_waitcnt vmcnt(0)" ::: "memory");
        } else {
            XB_SPIN(xb_ld(&bar[XB_XGEN(b.x)]) == gen, bar);
            __builtin_amdgcn_fence(__ATOMIC_ACQUIRE, "agent");
            asm volatile("s_waitcnt vmcnt(0)" ::: "memory");
        }
    }
    __syncthreads();
}

constexpr size_t WT_EIN = WS_WSMALL, WT_EOUT = WT_EIN + 4 * MiB, WT_EUP = WT_EOUT + 2 * MiB, WT_EDN = WT_EUP + 11 * MiB, WT_OIN = WT_EDN + 5 * MiB + 512 * KiB, WT_OOUT = WT_OIN + 6 * MiB;
constexpr size_t WT_MUP = WS_WMOE, WT_MDN = WS_WMOE + 112 * MiB;
static_assert(WT_OOUT + 2 * MiB <= WS_WMOE, "small weights");
__device__ __forceinline__ void cvt_item(const float* W, int K, int N, bf16_t* WT, int dst_row0, int k0, int n0, LAS float* scr, int lane) {
    const int rr = lane >> 3, cc = (lane & 7) * 4;
#pragma unroll
    for (int i = 0; i < 8; ++i) { const int kk = 8 * i + rr; const f32x4 v = *(const f32x4*)(W + (size_t)(k0 + kk) * N + n0 + cc); LAS float* s = scr + kk * 33 + cc; s[0] = v.x; s[1] = v.y; s[2] = v.z; s[3] = v.w; }
    asm volatile("s_waitcnt lgkmcnt(0)" ::: "memory");
    const int c = lane & 7;
#pragma unroll
    for (int j = 0; j < 4; ++j) { const int n = (lane >> 3) + 8 * j; const LAS float* s = scr + (8 * c) * 33 + n;
        u32x4 o; o.x = pk2(s[0 * 33], s[1 * 33]); o.y = pk2(s[2 * 33], s[3 * 33]); o.z = pk2(s[4 * 33], s[5 * 33]); o.w = pk2(s[6 * 33], s[7 * 33]);
        *(u32x4*)(WT + (size_t)(dst_row0 + n) * K + k0 + 8 * c) = o; }
    asm volatile("s_waitcnt lgkmcnt(0)" ::: "memory");
}
__device__ __forceinline__ void cvt_matrix_item(const float* W, int K, int N, bf16_t* WT, int mode, int item, LAS float* scr, int lane) {
    const int nblk = N / 32, kb = item / nblk, nb = item % nblk, n0 = 32 * nb;
    const int dst_row0 = mode == 0 ? n0 : ((n0 >> 7) * 256 + (n0 & 127) + 128 * (mode - 1));
    cvt_item(W, K, N, WT, dst_row0, 64 * kb, n0, scr, lane);
}
__device__ __forceinline__ void stage_convert(const P& p, LAS unsigned char* lds) {
    const int lane = threadIdx.x & 63, wave = __builtin_amdgcn_readfirstlane(threadIdx.x >> 6);
    LAS float* scr = (LAS float*)(lds + wave * 8448);
    const int gw = blockIdx.x * NWAVES + wave, NGW = gridDim.x * NWAVES;
    constexpr int I_EIN = 16 * 64, I_EOUT = 16 * 32, I_EUP = 16 * 88, I_EDN = 44 * 32, I_OIN = 16 * 96, I_OOUT = 16 * 32, I_MUP = 16 * 112, I_MDN = 56 * 32;
    constexpr int NSMALL = I_EIN + I_EOUT + 2 * I_EUP + I_EDN + I_OIN + I_OOUT, NITEMS = NSMALL + 8 * (2 * I_MUP + I_MDN);
    unsigned char* ws = p.ws;
    for (int it = gw; it < NITEMS; it += NGW) {
        int r = it;
        if (r < I_EIN) { cvt_matrix_item(p.in[E_W_IN], 1024, 2048, (bf16_t*)(ws + WT_EIN), 0, r, scr, lane); continue; } r -= I_EIN;
        if (r < I_EOUT) { cvt_matrix_item(p.in[E_W_OUT], 1024, 1024, (bf16_t*)(ws + WT_EOUT), 0, r, scr, lane); continue; } r -= I_EOUT;
        if (r < I_EUP) { cvt_matrix_item(p.in[E_FFN_WG], 1024, FFN, (bf16_t*)(ws + WT_EUP), 1, r, scr, lane); continue; } r -= I_EUP;
        if (r < I_EUP) { cvt_matrix_item(p.in[E_FFN_WU], 1024, FFN, (bf16_t*)(ws + WT_EUP), 2, r, scr, lane); continue; } r -= I_EUP;
        if (r < I_EDN) { cvt_matrix_item(p.in[E_FFN_WD], FFN, 1024, (bf16_t*)(ws + WT_EDN), 0, r, scr, lane); continue; } r -= I_EDN;
        if (r < I_OIN) { cvt_matrix_item(p.in[O_W_IN], 1024, 3072, (bf16_t*)(ws + WT_OIN), 0, r, scr, lane); continue; } r -= I_OIN;
        if (r < I_OOUT) { cvt_matrix_item(p.in[O_W_OUT], 1024, 1024, (bf16_t*)(ws + WT_OOUT), 0, r, scr, lane); continue; } r -= I_OOUT;
        const int e = r / (2 * I_MUP + I_MDN); r -= e * (2 * I_MUP + I_MDN);
        if (r < I_MUP) { cvt_matrix_item(p.in[O_MOE_WG] + (size_t)e * 1024 * ED, 1024, ED, (bf16_t*)(ws + WT_MUP) + (size_t)e * 2 * ED * 1024, 1, r, scr, lane); continue; } r -= I_MUP;
        if (r < I_MUP) { cvt_matrix_item(p.in[O_MOE_WU] + (size_t)e * 1024 * ED, 1024, ED, (bf16_t*)(ws + WT_MUP) + (size_t)e * 2 * ED * 1024, 2, r, scr, lane); continue; } r -= I_MUP;
        cvt_matrix_item(p.in[O_MOE_WD] + (size_t)e * ED * 1024, ED, 1024, (bf16_t*)(ws + WT_MDN) + (size_t)e * 1024 * ED, 0, r, scr, lane);
    }
}

__device__ __forceinline__ void stage_moba_naive(const P& p, LAS unsigned char* lds) {
    const bf16_t* Q = (const bf16_t*)(p.ws + WS_R + R_Q); const bf16_t* K = (const bf16_t*)(p.ws + WS_R + R_K); const bf16_t* V = (const bf16_t*)(p.ws + WS_R + R_V);
    const float* kpart = (const float*)(p.ws + WS_KPART); bf16_t* Y = (bf16_t*)(p.ws + WS_R + R_Y);
    LAS float* km = (LAS float*)lds;
    const int tid = threadIdx.x;
    for (int base = blockIdx.x * 512; base < NB * 8 * SEQ; base += gridDim.x * 512) {
        const int bh = base >> 12, h = bh & 7, b = bh >> 3, sb = base & 4095, own_max = (sb + 511) >> 8;
        for (int i = tid; i < own_max * 64; i += 512) { const int n = i >> 6, d = i & 63; float s = 0.f;
            for (int k = 0; k < 8; ++k) s += kpart[(size_t)(b * 128 + n * 8 + k) * 512 + h * 64 + d];
            km[i] = s * (1.f / 256.f); }
        __syncthreads();
        const int s = sb + tid; const size_t row = (size_t)b * SEQ + s; const int own = s >> 8;
        float q[64];
#pragma unroll
        for (int d = 0; d < 64; ++d) q[d] = bf2f(Q[row * 512 + h * 64 + d]);
        int s0 = -1, s1 = -1, s2 = -1; float g0 = -INFINITY, g1 = -INFINITY, g2 = -INFINITY;
        for (int n = 0; n < own; ++n) { float g = 0.f;
#pragma unroll
            for (int d = 0; d < 64; ++d) g += q[d] * km[n * 64 + d];
            if (g > g0) { g2 = g1; s2 = s1; g1 = g0; s1 = s0; g0 = g; s0 = n; } else if (g > g1) { g2 = g1; s2 = s1; g1 = g; s1 = n; } else if (g > g2) { g2 = g; s2 = n; } }
        float m = -INFINITY, l = 0.f, o[64];
#pragma unroll
        for (int d = 0; d < 64; ++d) o[d] = 0.f;
        for (int pass = 0; pass < 4; ++pass) {
            int blk, nk;
            if (pass == 0) { blk = s0; nk = 256; } else if (pass == 1) { blk = s1; nk = 256; } else if (pass == 2) { blk = s2; nk = 256; } else { blk = own; nk = (s & 255) + 1; }
            if (blk < 0) continue;
            for (int jk = 0; jk < nk; ++jk) { const size_t kr = ((size_t)b * SEQ + blk * 256 + jk) * 512 + h * 64; float sc = 0.f;
#pragma unroll
                for (int d8 = 0; d8 < 8; ++d8) { const u32x4 kv = *(const u32x4*)(K + kr + d8 * 8);
#pragma unroll
                    for (int i = 0; i < 4; ++i) { sc += q[d8 * 8 + 2 * i] * bf2f(kv[i] & 0xffffu); sc += q[d8 * 8 + 2 * i + 1] * bf2f(kv[i] >> 16); } }
                const float mn = fmaxf(m, sc), corr = exp2f(m - mn), pp = exp2f(sc - mn); l = l * corr + pp; m = mn;
#pragma unroll
                for (int d8 = 0; d8 < 8; ++d8) { const u32x4 vv = *(const u32x4*)(V + kr + d8 * 8);
#pragma unroll
                    for (int i = 0; i < 4; ++i) { o[d8 * 8 + 2 * i] = o[d8 * 8 + 2 * i] * corr + pp * bf2f(vv[i] & 0xffffu); o[d8 * 8 + 2 * i + 1] = o[d8 * 8 + 2 * i + 1] * corr + pp * bf2f(vv[i] >> 16); } }
            }
        }
        const float il = 1.f / l;
#pragma unroll
        for (int d8 = 0; d8 < 8; ++d8) { u32x4 w;
#pragma unroll
            for (int i = 0; i < 4; ++i) w[i] = pk2(o[d8 * 8 + 2 * i] * il, o[d8 * 8 + 2 * i + 1] * il);
            *(u32x4*)(Y + row * 1024 + 512 + h * 64 + d8 * 8) = w; }
        __syncthreads();
    }
}

struct Args { const float* in[N_IN]; float* out; unsigned char* ws; int ph_lo, ph_hi; };
constexpr int N_PHASES = 19;
__global__ void __launch_bounds__(NWAVES * 64, 2) mega_fwd(Args args) {
    extern __shared__ __attribute__((aligned(16))) unsigned char lds_raw[];
    LAS unsigned char* lds = (LAS unsigned char*)lds_raw;
    volatile LAS unsigned* MISC = (volatile LAS unsigned*)(lds + MISC_OFF);
    P p; for (int i = 0; i < N_IN; ++i) p.in[i] = args.in[i]; p.out = args.out; p.ws = args.ws;
    const int tid = threadIdx.x, G = gridDim.x;
    for (int u = tid; u < (LDS_BYTES - LDSCTL_OFF) / 4; u += NWAVES * 64) ((LAS unsigned*)(lds + LDSCTL_OFF))[u] = 0u;
    __syncthreads();
    const int lo = args.ph_lo, hi = args.ph_hi;
    const bool use_bar = (hi - lo) > 1;
    unsigned* ctl = (unsigned*)(p.ws + WS_CTL);
    XcdBarrier bar; bar.bar = ctl + CW_BAR; bar.x = 0; bar.st = nullptr;
    if (use_bar) bar = xcd_barrier_post(ctl + CW_BAR, MISC + 8);
#define IN(k) (lo <= (k) && (k) < hi)
#define SEAM(k) do { if (IN(k) && IN((k) + 1)) xcd_barrier(bar); } while (0)
    unsigned char* ws = p.ws;
    bf16_t* XN = (bf16_t*)(ws + WS_R + R_XN); bf16_t* U = (bf16_t*)(ws + WS_R + R_U); bf16_t* Y = (bf16_t*)(ws + WS_R + R_Y); bf16_t* H = (bf16_t*)(ws + WS_R + R_H);
    bf16_t* Xs = (bf16_t*)(ws + WS_XS); bf16_t* Hs = (bf16_t*)(ws + WS_R + R_HS);
    const float* modE = (const float*)(ws + WS_MOD); const float* modO = modE + 4 * 6144;
    const int* info = (const int*)(ws + WS_EXPINFO);
    typedef pg8::EpiBf16<0> EB;

    if (IN(0)) { stage_prep(p, (LAS float*)lds); __syncthreads(); stage_convert(p, lds); } SEAM(0);
    if (IN(1)) stage_norm<false>(p, p.in[I_X], p.in[E_NORM_MIX], modE, 0, 1024, XN); SEAM(1);
    if (IN(2)) { pg8::Gemm g{XN, (const bf16_t*)(ws + WT_EIN), T, 2048, DM}; pg8::StaticOrder S; S.init(T, 2048, G, (int)blockIdx.x);
        EB E{U, 2048, nullptr, 0, 0, 1.f}; pg8::gemm_phase<EB, pg8::StaticOrder, true, true>(lds, g, S, E); } SEAM(2);
    if (IN(3)) stage_griffin_local(p, lds); SEAM(3);
    if (IN(4)) stage_mix0_finish(p, lds); SEAM(4);
    if (IN(5)) { pg8::Gemm g{Y, (const bf16_t*)(ws + WT_EOUT), T, DM, DM}; pg8::StaticOrder S; S.init(T, DM, G, (int)blockIdx.x);
        pg8::EpiResid E{p.in[I_X], p.out, modE + 2048, DM}; pg8::gemm_phase<pg8::EpiResid, pg8::StaticOrder, true, true>(lds, g, S, E); } SEAM(5);
    if (IN(6)) stage_norm<false>(p, p.out, p.in[E_NORM_FFN], modE, 3072, 4096, XN); SEAM(6);
    if (IN(7)) { pg8::Gemm g{XN, (const bf16_t*)(ws + WT_EUP), T, 2 * FFN, DM}; pg8::StaticOrder S; S.init(T, 2 * FFN, G, (int)blockIdx.x);
        pg8::EpiSwiglu E{H, FFN}; pg8::gemm_phase<pg8::EpiSwiglu, pg8::StaticOrder, true, true>(lds, g, S, E); } SEAM(7);
    if (IN(8)) { pg8::Gemm g{H, (const bf16_t*)(ws + WT_EDN), T, DM, FFN}; pg8::StaticOrder S; S.init(T, DM, G, (int)blockIdx.x);
        pg8::EpiResid E{p.out, p.out, modE + 5120, DM}; pg8::gemm_phase<pg8::EpiResid, pg8::StaticOrder, true, true>(lds, g, S, E); } SEAM(8);
    if (IN(9)) stage_norm<false>(p, p.out, p.in[O_NORM_MIX], modO, 0, 1024, XN); SEAM(9);
    if (IN(10)) { pg8::Gemm g{XN, (const bf16_t*)(ws + WT_OIN), T, 3072, DM}; pg8::StaticOrder S; S.init(T, 3072, G, (int)blockIdx.x);
        EB E{U, 3072, nullptr, 0, 0, 1.f}; pg8::gemm_phase<EB, pg8::StaticOrder, true, true>(lds, g, S, E); } SEAM(10);
    if (IN(11)) stage_qkpost(p); SEAM(11);
    if (IN(12)) { stage_shortconv(p); stage_moba_naive(p, lds); } SEAM(12);
    if (IN(13)) { pg8::Gemm g{Y, (const bf16_t*)(ws + WT_OOUT), T, DM, DM}; pg8::StaticOrder S; S.init(T, DM, G, (int)blockIdx.x);
        pg8::EpiResid E{p.out, p.out, modO + 2048, DM}; pg8::gemm_phase<pg8::EpiResid, pg8::StaticOrder, true, true>(lds, g, S, E); } SEAM(13);
    if (IN(14)) stage_norm<true>(p, p.out, p.in[O_NORM_FFN], modO, 3072, 4096, XN); SEAM(14);
    if (IN(15)) stage_route_assign(p, (LAS int*)lds); SEAM(15);
    if (IN(16)) { pg8::Gemm g{Xs, (const bf16_t*)(ws + WT_MUP), MAXROWS, 2 * ED, DM}; pg8::GroupedOrder S; S.init(info, 2 * ED, G, (int)blockIdx.x);
        pg8::EpiSwiglu E{Hs, ED}; pg8::gemm_phase<pg8::EpiSwiglu, pg8::GroupedOrder, true, true>(lds, g, S, E); } SEAM(16);
    if (IN(17)) { pg8::Gemm g{Hs, (const bf16_t*)(ws + WT_MDN), MAXROWS, DM, ED}; pg8::GroupedOrder S; S.init(info, DM, G, (int)blockIdx.x);
        EB E{Xs, DM, nullptr, 0, 0, 1.f}; pg8::gemm_phase<EB, pg8::GroupedOrder, true, true>(lds, g, S, E); } SEAM(17);
    if (IN(18)) stage_combine(p);
#undef IN
#undef SEAM
}

extern "C" void kernel_launch(void* const* d_in, const int* in_sizes, int n_in, void* d_out, int out_size, void* d_ws, size_t ws_size, hipStream_t stream) {
    static int grid = 0;
    if (grid == 0) {
        if (n_in != N_IN || ws_size < WS_END || out_size != T * DM) { fprintf(stderr, "kernel_launch: n_in %d ws %zu (need %zu) out %d\n", n_in, ws_size, (size_t)WS_END, out_size); grid = -1; return; }
        int dev = 0, cus = 0, per_cu = 0;
        if (hipGetDevice(&dev) != hipSuccess || hipDeviceGetAttribute(&cus, hipDeviceAttributeMultiprocessorCount, dev) != hipSuccess) { grid = -1; return; }
        if (hipFuncSetAttribute((const void*)mega_fwd, hipFuncAttributeMaxDynamicSharedMemorySize, LDS_BYTES) != hipSuccess) { fprintf(stderr, "kernel_launch: hipFuncSetAttribute failed\n"); grid = -1; return; }
        if (hipOccupancyMaxActiveBlocksPerMultiprocessor(&per_cu, (const void*)mega_fwd, NWAVES * 64, LDS_BYTES) != hipSuccess || per_cu < 1) { fprintf(stderr, "kernel_launch: occupancy query says %d\n", per_cu); (void)hipGetLastError(); grid = -1; return; }
        grid = cus;
    }
    if (grid < 0) return;
    (void)hipMemsetAsync((char*)d_ws + WS_CTL, 0, CTL_BYTES, stream);
    Args a{};
    for (int i = 0; i < N_IN; ++i) a.in[i] = (const float*)d_in[i];
    a.out = (float*)d_out; a.ws = (unsigned char*)d_ws;
#ifndef MK_PER_PHASE
#define MK_PER_PHASE 0
#endif
    if (MK_PER_PHASE) { for (int k = 0; k < N_PHASES; ++k) { a.ph_lo = k; a.ph_hi = k + 1; hipLaunchKernelGGL(mega_fwd, dim3(grid), dim3(NWAVES * 64), LDS_BYTES, stream, a); } }
    else { a.ph_lo = 0; a.ph_hi = N_PHASES; hipLaunchKernelGGL(mega_fwd, dim3(grid), dim3(NWAVES * 64), LDS_BYTES, stream, a); }
}
```

```cpp
#include <hip/hip_runtime.h>
#include <cstdint>
#include <cstdio>

#define LAS __attribute__((address_space(3)))
typedef unsigned short bf16_t;
typedef short bf16x8 __attribute__((ext_vector_type(8)));
typedef float f32x4 __attribute__((ext_vector_type(4)));
typedef unsigned u32x4 __attribute__((ext_vector_type(4)));
typedef unsigned u32x2 __attribute__((ext_vector_type(2)));

constexpr int NB = 4, SEQ = 4096, DM = 1024, T = NB * SEQ;
constexpr int MIXW = 512, FFN = 2816, NE = 8, ED = 3584;
constexpr int MAXROWS = 34816;
constexpr float C2 = 0.125f * 1.4426950408889634f;

enum In { I_X = 0, I_C, E_ADA_W, E_ADA_B, E_NORM_MIX, E_NORM_FFN, E_W_IN, E_CONV_A_W, E_CONV_A_B, E_LN_A_G, E_LN_A_B, E_CONV_B_W, E_CONV_B_B,
          E_LRU_WA, E_LRU_BA, E_LRU_WX, E_LRU_BX, E_LRU_LAMBDA, E_W_OUT, E_FFN_WG, E_FFN_WU, E_FFN_WD,
          O_ADA_W, O_ADA_B, O_NORM_MIX, O_NORM_FFN, O_W_IN, O_CONV_C_W, O_Q_NORM, O_K_NORM, O_W_OUT, O_ROUTER_W, O_ROUTER_B, O_MOE_WG, O_MOE_WU, O_MOE_WD, N_IN };

constexpr size_t KiB = 1024, MiB = 1024 * 1024;
constexpr size_t WS_CTL = 0, CTL_BYTES = 128 * KiB;
constexpr size_t WS_MOD = 128 * KiB;
constexpr size_t WS_ROPE_C = 320 * KiB, WS_ROPE_S = 832 * KiB;
constexpr size_t WS_AAGG = 1344 * KiB, WS_HAGG = 1856 * KiB;
constexpr size_t WS_KPART = 2368 * KiB;
constexpr size_t WS_TOPE = 3392 * KiB, WS_TOPW = 3520 * KiB, WS_POS = 3648 * KiB;
constexpr size_t WS_EXPINFO = 3776 * KiB;
constexpr size_t WS_KMEAN = 3780 * KiB;
constexpr size_t WS_WSMALL = 4 * MiB;
constexpr size_t WS_WMOE = WS_WSMALL + 30 * MiB + 512 * KiB;
constexpr size_t WS_XS = WS_WMOE + 168 * MiB;
constexpr size_t WS_R = WS_XS + 68 * MiB;
constexpr size_t R_U = 0, R_HLP = 96 * MiB, R_Q = 96 * MiB, R_K = 112 * MiB, R_Y = 128 * MiB, R_XN = 160 * MiB, R_V = 192 * MiB, R_H = 0, R_HS = 0;
constexpr size_t WS_END = WS_R + 238 * MiB;

struct P {
    const float* in[N_IN];
    float* out;
    unsigned char* ws;
    int ph_lo, ph_hi;
    __device__ __forceinline__ const float* inp(int i) const {
        unsigned off = (unsigned)i * 8u; asm volatile("" : "+s"(off));
        const __attribute__((address_space(4))) char* ka = (const __attribute__((address_space(4))) char*)__builtin_amdgcn_kernarg_segment_ptr();
        return *(const float* const __attribute__((address_space(4)))*)(ka + off);
    }
};

__device__ __forceinline__ int ltid() { int t = (int)threadIdx.x; asm volatile("" : "+v"(t)); return t; }
__device__ __forceinline__ float bf2f(unsigned v) { return __uint_as_float(v << 16); }
__device__ __forceinline__ unsigned f2bf(float f) { unsigned u = __float_as_uint(f); return (u + 0x7fffu + ((u >> 16) & 1u)) >> 16; }
__device__ __forceinline__ unsigned pk2(float lo, float hi) { return f2bf(lo) | (f2bf(hi) << 16); }
__device__ __forceinline__ float wave_sum(float v) {
#pragma unroll
    for (int o = 1; o < 64; o <<= 1) v += __shfl_xor(v, o);
    return v;
}
__device__ __forceinline__ float sigmoidf_(float x) { return 1.f / (1.f + __expf(-x)); }
__device__ __forceinline__ float gelu_tanh(float x) { const float u = 0.7978845608028654f * (x + 0.044715f * x * x * x); return 0.5f * x * (1.f + tanhf(u)); }

__device__ __forceinline__ void stage_prep(const P& p, LAS float* red  ) {
    const int tid = ltid(), lane = tid & 63, wave = tid >> 6;
    float* mod = (float*)(p.ws + WS_MOD);
    for (int chunk = blockIdx.x; chunk < 192; chunk += gridDim.x) {
        const int L = chunk / 96, col0 = (chunk % 96) * 64;
        const float* W = p.inp(L ? O_ADA_W : E_ADA_W); const float* bias = p.inp(L ? O_ADA_B : E_ADA_B);
        float acc[4] = {0.f, 0.f, 0.f, 0.f};
        const int k0 = wave * 128; const float* cvec = p.inp(I_C);
#pragma unroll 4
        for (int k = k0; k < k0 + 128; ++k) {
            const float w = W[(size_t)k * 6144 + col0 + lane];
#pragma unroll
            for (int b = 0; b < 4; ++b) { const float cv = cvec[b * 1024 + k]; acc[b] += (cv / (1.f + __expf(-cv))) * w; }
        }
#pragma unroll
        for (int b = 0; b < 4; ++b) red[(wave * 4 + b) * 64 + lane] = acc[b];
        __syncthreads();
        if (tid < 256) { const int b = tid >> 6, l = tid & 63; float s = bias[col0 + l];
#pragma unroll
            for (int w = 0; w < 8; ++w) s += red[(w * 4 + b) * 64 + l];
            mod[(size_t)(L * 4 + b) * 6144 + col0 + l] = s; }
        __syncthreads();
    }
    float* rc = (float*)(p.ws + WS_ROPE_C); float* rs = (float*)(p.ws + WS_ROPE_S);
    for (int i = blockIdx.x * blockDim.x + tid; i < SEQ * 32; i += gridDim.x * blockDim.x) {
        const int pos = i >> 5, d = i & 31;
        const double inv = exp(-(double)d * (1.0 / 32.0) * 9.210340371976184);
        const double ang = (double)pos * inv;
        rc[i] = (float)cos(ang); rs[i] = (float)sin(ang);
    }
}

template <bool ROUTE>
__device__ __forceinline__ void stage_norm(const P& p, const float* X, const float* nw, const float* modL, int sh_off, int sc_off, bf16_t* XN) {
    const int tid_ = ltid(), lane = tid_ & 63, wave = tid_ >> 6, nwv = blockDim.x >> 6;
    const int gw = blockIdx.x * nwv + wave, NGW = gridDim.x * nwv;
    f32x4 w4[4];
#pragma unroll
    for (int j = 0; j < 4; ++j) w4[j] = *(const f32x4*)(nw + 4 * lane + 256 * j);
    const float* rw = p.inp(O_ROUTER_W); const float* rb = p.inp(O_ROUTER_B);
    int* tope = (int*)(p.ws + WS_TOPE); float* topw = (float*)(p.ws + WS_TOPW);
    for (int row = gw; row < T; row += NGW) {
        const int b = row >> 12;
        const f32x4* xr = (const f32x4*)(X + (size_t)row * DM) + lane;
        f32x4 v[4]; float ss = 0.f;
#pragma unroll
        for (int j = 0; j < 4; ++j) { v[j] = xr[64 * j]; ss += (v[j].x * v[j].x + v[j].y * v[j].y) + (v[j].z * v[j].z + v[j].w * v[j].w); }
        ss = wave_sum(ss);
        const float rstd = 1.0f / sqrtf(ss * (1.f / DM) + 1e-6f);
        const float* sc = modL + b * 6144 + sc_off; const float* sh = modL + b * 6144 + sh_off;
        float lg[8] = {0.f, 0.f, 0.f, 0.f, 0.f, 0.f, 0.f, 0.f};
#pragma unroll
        for (int j = 0; j < 4; ++j) {
            const f32x4 s4 = *(const f32x4*)(sc + 4 * lane + 256 * j), h4 = *(const f32x4*)(sh + 4 * lane + 256 * j);
            const f32x4 o = (v[j] * rstd) * w4[j] * (s4 + 1.f) + h4;
            u32x2 w; w.x = pk2(o.x, o.y); w.y = pk2(o.z, o.w);
            *(u32x2*)(XN + (size_t)row * DM + 4 * lane + 256 * j) = w;
            if (ROUTE) {
#pragma unroll
                for (int i = 0; i < 4; ++i) { const int k = 4 * lane + 256 * j + i; const f32x4 r0 = *(const f32x4*)(rw + k * 8), r1 = *(const f32x4*)(rw + k * 8 + 4);
                    lg[0] += o[i] * r0.x; lg[1] += o[i] * r0.y; lg[2] += o[i] * r0.z; lg[3] += o[i] * r0.w; lg[4] += o[i] * r1.x; lg[5] += o[i] * r1.y; lg[6] += o[i] * r1.z; lg[7] += o[i] * r1.w; }
            }
        }
        if (ROUTE) {
#pragma unroll
            for (int e = 0; e < 8; ++e) lg[e] = wave_sum(lg[e]) + rb[e];
            int e0 = 0; float l0 = lg[0];
#pragma unroll
            for (int e = 1; e < 8; ++e) if (lg[e] > l0) { l0 = lg[e]; e0 = e; }
            int e1 = -1; float l1 = -INFINITY;
#pragma unroll
            for (int e = 0; e < 8; ++e) if (e != e0 && lg[e] > l1) { l1 = lg[e]; e1 = e; }
            const float w0 = 1.f / (1.f + __expf(l1 - l0));
            if (lane == 0) { tope[row * 2] = e0; tope[row * 2 + 1] = e1; topw[row * 2] = w0; topw[row * 2 + 1] = 1.f - w0; }
        }
    }
}

constexpr int GL_WAVE_LDS = 10752;
__device__ __forceinline__ void stage_griffin_local(const P& p, LAS unsigned char* lds) {
    const int tid = ltid(), lane = tid & 63, wave = __builtin_amdgcn_readfirstlane(tid >> 6);
    LAS unsigned char* wl = lds + wave * GL_WAVE_LDS;
    LAS bf16_t* XA = (LAS bf16_t*)wl;
    LAS float* ZA = (LAS float*)(wl + 2304);
    LAS float* ZX = (LAS float*)(wl + 2304 + 4160);
    const int h = wave, c = 64 * h + lane, fr = lane & 15, fq = lane >> 4;
    const float cw0 = p.inp(E_CONV_B_W)[c], cw1 = p.inp(E_CONV_B_W)[512 + c], cw2 = p.inp(E_CONV_B_W)[1024 + c], cw3 = p.inp(E_CONV_B_W)[1536 + c], cb = p.inp(E_CONV_B_B)[c];
    const float ba = p.inp(E_LRU_BA)[c], bx = p.inp(E_LRU_BX)[c], lam = p.inp(E_LRU_LAMBDA)[c];
    const float lsl = fminf(lam, 0.f) - log1pf(expf(-fabsf(lam)));
    const float c8 = 8.0f * lsl;
    bf16x8 Ba[2][4], Bx[2][4];
    { const float* wa = p.inp(E_LRU_WA) + h * 4096; const float* wx = p.inp(E_LRU_WX) + h * 4096;
#pragma unroll
      for (int ks = 0; ks < 2; ++ks)
#pragma unroll
          for (int nt = 0; nt < 4; ++nt)
#pragma unroll
              for (int jj = 0; jj < 8; ++jj) { const int k = 32 * ks + 8 * fq + jj, n = 16 * nt + fr;
                  Ba[ks][nt][jj] = (short)f2bf(wa[k * 64 + n]); Bx[ks][nt][jj] = (short)f2bf(wx[k * 64 + n]); } }
    const bf16_t* U = (const bf16_t*)(p.ws + WS_R + R_U);
    unsigned* HLP = (unsigned*)(p.ws + WS_R + R_HLP);
    float* Aagg = (float*)(p.ws + WS_AAGG); float* Hagg = (float*)(p.ws + WS_HAGG);
    for (int tl = blockIdx.x; tl < 256; tl += gridDim.x) {
        const int b = tl >> 6, j = tl & 63; const size_t row0 = (size_t)b * SEQ + j * 64;
        float x1 = 0.f, x2 = 0.f, x3 = 0.f;
        if (j != 0) { x1 = bf2f(U[(row0 - 1) * 2048 + 1024 + c]); x2 = bf2f(U[(row0 - 2) * 2048 + 1024 + c]); x3 = bf2f(U[(row0 - 3) * 2048 + 1024 + c]); }
        float hst = 0.f, pc = 1.f;
        for (int mt = 0; mt < 4; ++mt) {
            float xb[16];
#pragma unroll
            for (int r = 0; r < 16; ++r) { const float xn = bf2f(U[(row0 + 16 * mt + r) * 2048 + 1024 + c]);
                xb[r] = cb + cw0 * x3 + cw1 * x2 + cw2 * x1 + cw3 * xn; x3 = x2; x2 = x1; x1 = xn; XA[r * 72 + lane] = (bf16_t)f2bf(xb[r]); }
            const bf16x8 a0 = *(const LAS bf16x8*)((LAS unsigned char*)XA + fr * 144 + fq * 16);
            const bf16x8 a1 = *(const LAS bf16x8*)((LAS unsigned char*)XA + fr * 144 + fq * 16 + 64);
#pragma unroll
            for (int nt = 0; nt < 4; ++nt) {
                f32x4 za = {0.f, 0.f, 0.f, 0.f}, zx = {0.f, 0.f, 0.f, 0.f};
                za = __builtin_amdgcn_mfma_f32_16x16x32_bf16(a0, Ba[0][nt], za, 0, 0, 0); za = __builtin_amdgcn_mfma_f32_16x16x32_bf16(a1, Ba[1][nt], za, 0, 0, 0);
                zx = __builtin_amdgcn_mfma_f32_16x16x32_bf16(a0, Bx[0][nt], zx, 0, 0, 0); zx = __builtin_amdgcn_mfma_f32_16x16x32_bf16(a1, Bx[1][nt], zx, 0, 0, 0);
#pragma unroll
                for (int r4 = 0; r4 < 4; ++r4) { ZA[(4 * fq + r4) * 65 + 16 * nt + fr] = za[r4]; ZX[(4 * fq + r4) * 65 + 16 * nt + fr] = zx[r4]; }
            }
#pragma unroll
            for (int r = 0; r < 16; ++r) {
                const float rg = sigmoidf_(ZA[r * 65 + lane] + ba), ig = sigmoidf_(ZX[r * 65 + lane] + bx);
                const float la = c8 * rg, a = __expf(la), mult = sqrtf(-expm1f(2.f * la));
                hst = a * hst + mult * ig * xb[r]; pc *= a;
                HLP[(row0 + 16 * mt + r) * 512 + c] = f2bf(hst) | (f2bf(pc) << 16);
            }
        }
        Aagg[tl * 512 + c] = pc; Hagg[tl * 512 + c] = hst;
    }
}

constexpr int MF_LDS = 95 * 1024;
__device__ __forceinline__ void stage_mix0_finish(const P& p, LAS unsigned char* lds) {
    const int tid = ltid(), lane = tid & 63, wave = __builtin_amdgcn_readfirstlane(tid >> 6);
    const bf16_t* U = (const bf16_t*)(p.ws + WS_R + R_U);
    const unsigned* HLP = (const unsigned*)(p.ws + WS_R + R_HLP);
    const float* Aagg = (const float*)(p.ws + WS_AAGG); const float* Hagg = (const float*)(p.ws + WS_HAGG);
    bf16_t* Y = (bf16_t*)(p.ws + WS_R + R_Y);
    LAS bf16_t* G = (LAS bf16_t*)lds;
    for (int tl = blockIdx.x; tl < 256; tl += gridDim.x) {
        const int b = tl >> 6, j = tl & 63; const size_t row0 = (size_t)b * SEQ + j * 64;
        for (int idx = tid; idx < 95 * 64; idx += 512) {
            const int rho = idx >> 6, ch8 = (idx & 63) * 8, tpos = j * 64 - 30 + rho;
            u32x4 o = {0u, 0u, 0u, 0u};
            if (tpos >= 0 && rho < 94) { const size_t row = (size_t)b * SEQ + tpos;
                const u32x4 av = *(const u32x4*)(U + row * 2048 + ch8), gv = *(const u32x4*)(U + row * 2048 + 512 + ch8);
#pragma unroll
                for (int i = 0; i < 4; ++i) { const float a0 = bf2f(av[i] & 0xffffu), a1 = bf2f(av[i] >> 16), g0 = bf2f(gv[i] & 0xffffu), g1 = bf2f(gv[i] >> 16);
                    o[i] = pk2(a0 * sigmoidf_(g0), a1 * sigmoidf_(g1)); } }
            *(LAS u32x4*)(G + rho * 512 + ch8) = o;
        }
        { const int c = tid; float carry = 0.f;
          for (int jj = 0; jj < j; ++jj) carry = Aagg[(b * 64 + jj) * 512 + c] * carry + Hagg[(b * 64 + jj) * 512 + c];
#pragma unroll 8
          for (int r = 0; r < 64; ++r) { const size_t row = row0 + r; const unsigned hp = HLP[row * 512 + c];
              const float hv = bf2f(hp & 0xffffu) + bf2f(hp >> 16) * carry; const float g = bf2f(U[row * 2048 + 1536 + c]);
              Y[row * 1024 + 512 + c] = (bf16_t)f2bf(hv * gelu_tanh(g)); } }
        __syncthreads();
        f32x4 res[2][8];
        const float* caw = p.inp(E_CONV_A_W);
#pragma unroll
        for (int ps = 0; ps < 2; ++ps) {
            const int c0 = 256 * ps + 4 * lane;
            const f32x4 bias = *(const f32x4*)(p.inp(E_CONV_A_B) + c0);
#pragma unroll
            for (int o = 0; o < 8; ++o) res[ps][o] = bias;
#pragma unroll 1
            for (int jb = 0; jb < 32; jb += 8) {
                f32x4 wv[8], xw[15];
#pragma unroll
                for (int t = 0; t < 8; ++t) { const int jj = jb + t; wv[t] = *(const f32x4*)(caw + (jj < 30 ? jj : 30) * 512 + c0) * (jj <= 30 ? 1.f : 0.f); }
#pragma unroll
                for (int r = 0; r < 15; ++r) { const u32x2 raw = *(const LAS u32x2*)(G + (8 * wave + jb + r) * 512 + c0);
                    xw[r] = (f32x4){bf2f(raw.x & 0xffffu), bf2f(raw.x >> 16), bf2f(raw.y & 0xffffu), bf2f(raw.y >> 16)}; }
#pragma unroll
                for (int o = 0; o < 8; ++o)
#pragma unroll
                    for (int t = 0; t < 8; ++t) res[ps][o] += wv[t] * xw[o + t];
            }
        }
        { const f32x4 g0 = *(const f32x4*)(p.inp(E_LN_A_G) + 4 * lane), g1 = *(const f32x4*)(p.inp(E_LN_A_G) + 256 + 4 * lane);
          const f32x4 b0 = *(const f32x4*)(p.inp(E_LN_A_B) + 4 * lane), b1 = *(const f32x4*)(p.inp(E_LN_A_B) + 256 + 4 * lane);
#pragma unroll
          for (int o = 0; o < 8; ++o) {
              float s = (res[0][o].x + res[0][o].y) + (res[0][o].z + res[0][o].w) + (res[1][o].x + res[1][o].y) + (res[1][o].z + res[1][o].w);
              const float mean = wave_sum(s) * (1.f / 512.f);
              const f32x4 d0 = res[0][o] - mean, d1 = res[1][o] - mean;
              float q = (d0.x * d0.x + d0.y * d0.y) + (d0.z * d0.z + d0.w * d0.w) + (d1.x * d1.x + d1.y * d1.y) + (d1.z * d1.z + d1.w * d1.w);
              const float rstd = 1.0f / sqrtf(wave_sum(q) * (1.f / 512.f) + 1e-6f);
              f32x4 y0 = d0 * rstd * g0 + b0, y1 = d1 * rstd * g1 + b1;
              const size_t row = row0 + 8 * wave + o;
              u32x2 w0, w1;
              w0.x = pk2(y0.x * sigmoidf_(y0.x), y0.y * sigmoidf_(y0.y)); w0.y = pk2(y0.z * sigmoidf_(y0.z), y0.w * sigmoidf_(y0.w));
              w1.x = pk2(y1.x * sigmoidf_(y1.x), y1.y * sigmoidf_(y1.y)); w1.y = pk2(y1.z * sigmoidf_(y1.z), y1.w * sigmoidf_(y1.w));
              *(u32x2*)(Y + row * 1024 + 4 * lane) = w0; *(u32x2*)(Y + row * 1024 + 256 + 4 * lane) = w1;
          } }
        __syncthreads();
    }
}

__device__ __forceinline__ void stage_qkpost(const P& p) {
    const int tid_ = ltid(), lane = tid_ & 63, wave = tid_ >> 6, nwv = blockDim.x >> 6;
    const int gw = blockIdx.x * nwv + wave, NGW = gridDim.x * nwv;
    const bf16_t* U = (const bf16_t*)(p.ws + WS_R + R_U);
    bf16_t* Q = (bf16_t*)(p.ws + WS_R + R_Q); bf16_t* K = (bf16_t*)(p.ws + WS_R + R_K); bf16_t* V = (bf16_t*)(p.ws + WS_R + R_V);
    float* kpart = (float*)(p.ws + WS_KPART);
    const float* rc = (const float*)(p.ws + WS_ROPE_C); const float* rs = (const float*)(p.ws + WS_ROPE_S);
    const int i8 = lane & 7, dd = 8 * (i8 & 3); const bool hi = i8 >= 4;
    float qn[8], kn[8];
#pragma unroll
    for (int i = 0; i < 8; ++i) { qn[i] = p.inp(O_Q_NORM)[8 * i8 + i]; kn[i] = p.inp(O_K_NORM)[8 * i8 + i]; }
    for (int g = gw; g < T / 32; g += NGW) {
        float ksum[8] = {0.f, 0.f, 0.f, 0.f, 0.f, 0.f, 0.f, 0.f};
        for (int r = 0; r < 32; ++r) {
            const size_t row = (size_t)g * 32 + r; const int pos = (int)(row & (SEQ - 1));
            const f32x4 c0 = *(const f32x4*)(rc + pos * 32 + dd), c1 = *(const f32x4*)(rc + pos * 32 + dd + 4);
            const f32x4 s0 = *(const f32x4*)(rs + pos * 32 + dd), s1 = *(const f32x4*)(rs + pos * 32 + dd + 4);
            const float cs[8] = {c0.x, c0.y, c0.z, c0.w, c1.x, c1.y, c1.z, c1.w}, sn[8] = {s0.x, s0.y, s0.z, s0.w, s1.x, s1.y, s1.z, s1.w};
#pragma unroll
            for (int which = 0; which < 2; ++which) {
                const u32x4 raw = *(const u32x4*)(U + row * 3072 + 1536 + 512 * which + 8 * lane);
                float v[8];
#pragma unroll
                for (int i = 0; i < 4; ++i) { v[2 * i] = bf2f(raw[i] & 0xffffu); v[2 * i + 1] = bf2f(raw[i] >> 16); }
                float ss = 0.f;
#pragma unroll
                for (int i = 0; i < 8; ++i) ss += v[i] * v[i];
                ss += __shfl_xor(ss, 1); ss += __shfl_xor(ss, 2); ss += __shfl_xor(ss, 4);
                const float rstd = 1.0f / sqrtf(ss * (1.f / 64.f) + 1e-6f);
                float o[8];
#pragma unroll
                for (int i = 0; i < 8; ++i) { v[i] = v[i] * rstd * (which ? kn[i] : qn[i]); }
#pragma unroll
                for (int i = 0; i < 8; ++i) { const float pv = __shfl_xor(v[i], 4); o[i] = hi ? (v[i] * cs[i] + pv * sn[i]) : (v[i] * cs[i] - pv * sn[i]); }
                u32x4 w;
                if (which == 0) {
#pragma unroll
                    for (int i = 0; i < 4; ++i) w[i] = pk2(o[2 * i] * C2, o[2 * i + 1] * C2);
                    *(u32x4*)(Q + row * 512 + 8 * lane) = w;
                } else {
#pragma unroll
                    for (int i = 0; i < 8; ++i) ksum[i] += o[i];
#pragma unroll
                    for (int i = 0; i < 4; ++i) w[i] = pk2(o[2 * i], o[2 * i + 1]);
                    *(u32x4*)(K + row * 512 + 8 * lane) = w;
                }
            }
            *(u32x4*)(V + row * 512 + 8 * lane) = *(const u32x4*)(U + row * 3072 + 2560 + 8 * lane);
        }
        *(f32x4*)(kpart + (size_t)g * 512 + 8 * lane) = (f32x4){ksum[0], ksum[1], ksum[2], ksum[3]};
        *(f32x4*)(kpart + (size_t)g * 512 + 8 * lane + 4) = (f32x4){ksum[4], ksum[5], ksum[6], ksum[7]};
    }
}

__device__ __forceinline__ void stage_shortconv(const P& p) {
    const bf16_t* U = (const bf16_t*)(p.ws + WS_R + R_U);
    bf16_t* Y = (bf16_t*)(p.ws + WS_R + R_Y);
    const float* cw = p.inp(O_CONV_C_W);
    for (int idx = blockIdx.x * blockDim.x + ltid(); idx < T * 64; idx += gridDim.x * blockDim.x) {
        const size_t row = idx >> 6; const int ch8 = (idx & 63) * 8, pos = (int)(row & (SEQ - 1));
        float acc[8] = {0.f, 0.f, 0.f, 0.f, 0.f, 0.f, 0.f, 0.f};
#pragma unroll
        for (int jj = 0; jj < 3; ++jj) {
            if (pos - 2 + jj < 0) continue;
            const size_t r2 = row - 2 + jj;
            const u32x4 hv = *(const u32x4*)(U + r2 * 3072 + ch8), cv = *(const u32x4*)(U + r2 * 3072 + 1024 + ch8);
            const f32x4 wa = *(const f32x4*)(cw + jj * 512 + ch8), wb = *(const f32x4*)(cw + jj * 512 + ch8 + 4);
            const float w[8] = {wa.x, wa.y, wa.z, wa.w, wb.x, wb.y, wb.z, wb.w};
#pragma unroll
            for (int i = 0; i < 4; ++i) { acc[2 * i] += w[2 * i] * (bf2f(hv[i] & 0xffffu) * bf2f(cv[i] & 0xffffu)); acc[2 * i + 1] += w[2 * i + 1] * (bf2f(hv[i] >> 16) * bf2f(cv[i] >> 16)); }
        }
        const u32x4 bv = *(const u32x4*)(U + row * 3072 + 512 + ch8);
        u32x4 o;
#pragma unroll
        for (int i = 0; i < 4; ++i) o[i] = pk2(acc[2 * i] * bf2f(bv[i] & 0xffffu), acc[2 * i + 1] * bf2f(bv[i] >> 16));
        *(u32x4*)(Y + row * 1024 + ch8) = o;
    }
}

__device__ __forceinline__ void stage_route_assign(const P& p, LAS int* li  ) {
    const int tid = ltid(), lane = tid & 63;
    const int* tope = (const int*)(p.ws + WS_TOPE); int* posk = (int*)(p.ws + WS_POS); int* info = (int*)(p.ws + WS_EXPINFO);
    const bf16_t* XN = (const bf16_t*)(p.ws + WS_R + R_XN); bf16_t* Xs = (bf16_t*)(p.ws + WS_XS);
    LAS int* tot = li; LAS int* bef = li + 8; LAS int* base = li + 16; LAS int* lpos = li + 64;
    for (int chunk = blockIdx.x; chunk < 256; chunk += gridDim.x) {
        if (tid < 16) li[tid] = 0;
        __syncthreads();
        int ct[8] = {0, 0, 0, 0, 0, 0, 0, 0}, cb[8] = {0, 0, 0, 0, 0, 0, 0, 0};
        for (int tok = tid; tok < T; tok += 512) {
            const int e0 = tope[tok * 2], e1 = tope[tok * 2 + 1]; const bool before = tok < chunk * 64;
#pragma unroll
            for (int e = 0; e < 8; ++e) {
                ct[e] += __popcll(__ballot(e0 == e)) + __popcll(__ballot(e1 == e));
                cb[e] += __popcll(__ballot(before && e0 == e)) + __popcll(__ballot(before && e1 == e));
            }
        }
        if (lane == 0) {
#pragma unroll
            for (int e = 0; e < 8; ++e) { atomicAdd((int*)&tot[e], ct[e]); atomicAdd((int*)&bef[e], cb[e]); }
        }
        __syncthreads();
        if (tid == 0) {
            int run = 0; int pst[8], pad[8];
#pragma unroll
            for (int e = 0; e < 8; ++e) { pad[e] = (tot[e] + 255) / 256 * 256; pst[e] = run; run += pad[e]; base[e] = pst[e] + bef[e]; }
            if (chunk == 0) { info[0] = run / 256; info[1] = run;
                for (int blk = 0; blk < run / 256; ++blk) { int ee = 7;
#pragma unroll
                    for (int e = 7; e >= 0; --e) if (blk * 256 < pst[e] + pad[e]) ee = e;
                    info[16 + blk] = ee; } }
            for (int t = 0; t < 64; ++t) { const int tok = chunk * 64 + t;
                for (int k = 0; k < 2; ++k) { const int e = tope[tok * 2 + k]; const int ps = base[e]; base[e] = ps + 1; posk[tok * 2 + k] = ps; lpos[t * 2 + k] = ps; } }
        }
        __syncthreads();
        for (int idx = tid; idx < 128 * 128; idx += 512) { const int a = idx >> 7, ch = idx & 127; const int tok = chunk * 64 + (a >> 1); const int ps = lpos[a];
            *(u32x4*)(Xs + (size_t)ps * 1024 + ch * 8) = *(const u32x4*)(XN + (size_t)tok * 1024 + ch * 8); }
        __syncthreads();
    }
}

__device__ __forceinline__ void stage_combine(const P& p) {
    const int tid_ = ltid(), lane = tid_ & 63, wave = tid_ >> 6, nwv = blockDim.x >> 6;
    const int gw = blockIdx.x * nwv + wave, NGW = gridDim.x * nwv;
    const int* posk = (const int*)(p.ws + WS_POS); const float* topw = (const float*)(p.ws + WS_TOPW);
    const bf16_t* Ys = (const bf16_t*)(p.ws + WS_XS); const float* modO = (const float*)(p.ws + WS_MOD) + 4 * 6144;
    for (int row = gw; row < T; row += NGW) {
        const int b = row >> 12; const int p0 = posk[row * 2], p1 = posk[row * 2 + 1]; const float w0 = topw[row * 2], w1 = topw[row * 2 + 1];
#pragma unroll
        for (int j = 0; j < 4; ++j) { const int col = 4 * lane + 256 * j;
            const u32x2 a = *(const u32x2*)(Ys + (size_t)p0 * 1024 + col), c = *(const u32x2*)(Ys + (size_t)p1 * 1024 + col);
            const f32x4 g = *(const f32x4*)(modO + b * 6144 + 5120 + col);
            f32x4 x = *(const f32x4*)(p.out + (size_t)row * DM + col);
            f32x4 m; m.x = w0 * bf2f(a.x & 0xffffu) + w1 * bf2f(c.x & 0xffffu); m.y = w0 * bf2f(a.x >> 16) + w1 * bf2f(c.x >> 16);
            m.z = w0 * bf2f(a.y & 0xffffu) + w1 * bf2f(c.y & 0xffffu); m.w = w0 * bf2f(a.y >> 16) + w1 * bf2f(c.y >> 16);
            *(f32x4*)(p.out + (size_t)row * DM + col) = x + g * m; }
    }
}


constexpr int NWAVES = 8;
constexpr int RING_BYTES = 131072, LDSCTL_OFF = RING_BYTES, MISC_OFF = LDSCTL_OFF + 320, LDS_BYTES = 147456;
constexpr int CW_BAR = 1024;
typedef __attribute__((address_space(1))) unsigned gu32;
#define RLX_AGENT __ATOMIC_RELAXED, __HIP_MEMORY_SCOPE_AGENT
namespace pg8 {
#define PG8_LAS __attribute__((address_space(3)))
typedef unsigned short bf16_t;
typedef short bf16x8 __attribute__((ext_vector_type(8)));
typedef float f32x4 __attribute__((ext_vector_type(4)));
typedef unsigned u32x4 __attribute__((ext_vector_type(4)));
constexpr int BM = 256, BK = 64, HALF = 128, HTB = HALF * BK * 2  , STAGE_BYTES = 8 * HTB, NXCD = 8, WGM = 8;

__host__ __device__ __forceinline__ int lds_byte(int r, int c) { const int st = (r >> 4) * 2 + (c >> 5), rr = r & 15, cc = c & 31, ob = rr * 64 + cc * 2; return st * 1024 + (ob ^ (((ob >> 9) & 1) << 5)); }
__host__ __device__ __forceinline__ void stage_rc(int b, int& R, int& C) { const int st = b / 1024, sb = b % 1024, swz = sb ^ (((sb >> 9) & 1) << 5); R = (st >> 1) * 16 + swz / 64; C = (st & 1) * 32 + (swz % 64) / 2; }
__host__ __device__ __forceinline__ int perm32(int rho) { const int n = rho >> 4, i = rho & 15; return 8 * (i >> 2) + 4 * n + (i & 3); }

struct Unit { int pm, pn, bt; };
struct Gemm { const bf16_t* A; const bf16_t* Bt; int M, N, K; };

struct StaticOrder {
    int nM, nN, nwg, G, c;
    __host__ __device__ void init(int M, int N, int G_, int c_) { nM = M / BM; nN = N / BM; nwg = nM * nN; G = G_; c = c_; }
    __host__ __device__ bool next(int i, Unit& u) const {
        const long L = (long)i * G + c; if (L >= nwg) return false;
        int wgid = (int)L; { const int q = nwg / NXCD, r = nwg % NXCD, xcd = wgid % NXCD, off = wgid / NXCD; wgid = (xcd < r ? xcd * (q + 1) : r * (q + 1) + (xcd - r) * q) + off; }
        const int nig = WGM * nN, gid = wgid / nig, fm = gid * WGM, gsz = (nM - fm) < WGM ? (nM - fm) : WGM;
        u.pm = fm + ((wgid % nig) % gsz); u.pn = (wgid % nig) / gsz; u.bt = u.pn; return true;
    }
    __device__ __forceinline__ void a_ready(const Unit&) const {}
    __device__ __forceinline__ void done(const Unit&) const {}
};

__device__ __forceinline__ unsigned cvt_pk_bf16(float lo, float hi) { unsigned r; asm volatile("v_cvt_pk_bf16_f32 %0, %1, %2" : "=v"(r) : "v"(lo), "v"(hi)); return r; }
typedef float f32x2 __attribute__((ext_vector_type(2)));
__device__ __forceinline__ f32x2 gelu_pk(f32x2 v) {
    const f32x2 av = __builtin_elementwise_abs(v), d = av * 0.2316418882f + 1.0f;
    f32x2 t; t.x = __builtin_amdgcn_rcpf(d.x); t.y = __builtin_amdgcn_rcpf(d.y);
    f32x2 q = t * 0.5307027145f + (-0.7265760135f); q = q * t + 0.7107068705f; q = q * t + (-0.142248368f); q = q * t + 0.127414796f; q = q * t;
    const f32x2 s = (v * v) * (-0.72134752044f);
    f32x2 e; e.x = __builtin_amdgcn_exp2f(s.x); e.y = __builtin_amdgcn_exp2f(s.y);
    const f32x2 m = v * (q * e), r = v - m;
    f32x2 o; o.x = v.x < 0.f ? m.x : r.x; o.y = v.y < 0.f ? m.y : r.y; return o;
}

template <int ACT  > struct EpiBf16 {
    static constexpr bool PERM = true, AFTER_DRAIN = false; static_assert(ACT == 0 || ACT == 1, "EpiBf16: ACT is 0 (none) or 1 (gelu_pk)");
    bf16_t* O; int ldc; const float* bias; int split_cols; size_t split_stride; float scale0;
    __device__ __forceinline__ void operator()(const f32x4 (&acc)[2][2][4][2], const Unit& u, int wr, int wc, int fr, int fq) const {
        const int row0 = u.pm * BM + wr * 64 + fr; int colt = u.pn * BM; bf16_t* base = O;
        float sc = 1.f; if (split_cols) { const int t = colt / split_cols; base += (size_t)t * split_stride; colt -= t * split_cols; if (t == 0) sc = scale0; }
        const int col0 = colt + wc * 32 + 8 * fq, bcol0 = u.pn * BM + wc * 32 + 8 * fq;
        f32x4 bv[2][2];
#pragma unroll
        for (int bj = 0; bj < 2; ++bj)
#pragma unroll
            for (int n = 0; n < 2; ++n) bv[bj][n] = bias ? *(const f32x4*)(bias + bcol0 + bj * HALF + 4 * n) : (f32x4){0.f, 0.f, 0.f, 0.f};
#pragma unroll
        for (int ai = 0; ai < 2; ++ai)
#pragma unroll
            for (int m = 0; m < 4; ++m) { bf16_t* rowp = base + (size_t)(row0 + ai * HALF + m * 16) * ldc + col0;
#pragma unroll
                for (int bj = 0; bj < 2; ++bj) { f32x4 v0 = acc[ai][bj][m][0] + bv[bj][0], v1 = acc[ai][bj][m][1] + bv[bj][1];
                    if (ACT == 1) { f32x2 a = gelu_pk((f32x2){v0[0], v0[1]}), b = gelu_pk((f32x2){v0[2], v0[3]}), c = gelu_pk((f32x2){v1[0], v1[1]}), d = gelu_pk((f32x2){v1[2], v1[3]});
                        v0 = (f32x4){a.x, a.y, b.x, b.y}; v1 = (f32x4){c.x, c.y, d.x, d.y}; }
                    v0 = v0 * sc; v1 = v1 * sc; u32x4 w; w.x = cvt_pk_bf16(v0[0], v0[1]); w.y = cvt_pk_bf16(v0[2], v0[3]); w.z = cvt_pk_bf16(v1[0], v1[1]); w.w = cvt_pk_bf16(v1[2], v1[3]);
                    *(u32x4*)(rowp + bj * HALF) = w; } }
    }
};

struct EpiResid {
    static constexpr bool PERM = false, AFTER_DRAIN = false;
    const float* base; float* out; const float* gate; int ldc;
    __device__ __forceinline__ void operator()(const f32x4 (&acc)[2][2][4][2], const Unit& u, int wr, int wc, int fr, int fq) const {
        const int row0 = u.pm * BM + wr * 64 + fr, col0 = u.pn * BM + wc * 32 + 4 * fq;
        const float* gb = gate + ((u.pm * BM) >> 12) * 6144 + col0;
        f32x4 gv[2][2];
#pragma unroll
        for (int bj = 0; bj < 2; ++bj)
#pragma unroll
            for (int n = 0; n < 2; ++n) gv[bj][n] = *(const f32x4*)(gb + bj * HALF + n * 16);
#pragma unroll
        for (int ai = 0; ai < 2; ++ai)
#pragma unroll
            for (int m = 0; m < 4; ++m) { const size_t off = (size_t)(row0 + ai * HALF + m * 16) * ldc + col0;
#pragma unroll
                for (int bj = 0; bj < 2; ++bj)
#pragma unroll
                    for (int n = 0; n < 2; ++n) { const f32x4 bs = *(const f32x4*)(base + off + bj * HALF + n * 16); *(f32x4*)(out + off + bj * HALF + n * 16) = bs + gv[bj][n] * acc[ai][bj][m][n]; } }
    }
};
struct EpiSwiglu {
    static constexpr bool PERM = true, AFTER_DRAIN = false;
    bf16_t* O; int ldo;
    __device__ __forceinline__ void operator()(const f32x4 (&acc)[2][2][4][2], const Unit& u, int wr, int wc, int fr, int fq) const {
        const int row0 = u.pm * BM + wr * 64 + fr, hcol0 = u.pn * HALF + wc * 32 + 8 * fq;
#pragma unroll
        for (int ai = 0; ai < 2; ++ai)
#pragma unroll
            for (int m = 0; m < 4; ++m) { bf16_t* rowp = O + (size_t)(row0 + ai * HALF + m * 16) * ldo + hcol0;
                float h[8];
#pragma unroll
                for (int n = 0; n < 2; ++n)
#pragma unroll
                    for (int i = 0; i < 4; ++i) { const float g = acc[ai][0][m][n][i], up = acc[ai][1][m][n][i]; h[4 * n + i] = g * __builtin_amdgcn_rcpf(1.f + __expf(-g)) * up; }
                u32x4 w; w.x = cvt_pk_bf16(h[0], h[1]); w.y = cvt_pk_bf16(h[2], h[3]); w.z = cvt_pk_bf16(h[4], h[5]); w.w = cvt_pk_bf16(h[6], h[7]);
                *(u32x4*)rowp = w; }
    }
};
struct GroupedOrder {
    const int* info; int nM, nN, nwg, G, c;
    __device__ void init(const int* info_, int N, int G_, int c_) { info = info_; nM = __builtin_amdgcn_readfirstlane(info_[0]); nN = N / BM; nwg = nM * nN; G = G_; c = c_; }
    __device__ bool next(int i, Unit& u) const {
        const long L = (long)i * G + c; if (L >= nwg) return false;
        int wgid = (int)L; { const int q = nwg / NXCD, r = nwg % NXCD, xcd = wgid % NXCD, off = wgid / NXCD; wgid = (xcd < r ? xcd * (q + 1) : r * (q + 1) + (xcd - r) * q) + off; }
        const int nig = WGM * nN, gid = wgid / nig, fm = gid * WGM, gsz = (nM - fm) < WGM ? (nM - fm) : WGM;
        u.pm = fm + ((wgid % nig) % gsz); u.pn = (wgid % nig) / gsz; u.bt = __builtin_amdgcn_readfirstlane(info[16 + u.pm]) * nN + u.pn; return true;
    }
    __device__ __forceinline__ void a_ready(const Unit&) const {}
    __device__ __forceinline__ void done(const Unit&) const {}
};

template <class Epi, class Sched, bool ALIGN_EPI = false, bool SP2 = false>
__device__ __forceinline__ void gemm_phase(PG8_LAS unsigned char* lds, const Gemm g, const Sched& S, const Epi& E) {
    const int tid = ltid(), wid = __builtin_amdgcn_readfirstlane(tid >> 6), lane = tid & 63, wr = wid >> 2, wc = wid & 3, fr = lane & 15, fq = lane >> 4;
    const int K = g.K, nt = K / BK;
    unsigned voffA[2], voffB[2];
#pragma unroll
    for (int i = 0; i < 2; ++i) { int R, C; stage_rc(tid * 16 + i * 8192, R, C); const int Rb = Epi::PERM ? ((R & ~31) + perm32(R & 31)) : R;
        voffA[i] = (unsigned)(R * K + C) * 2u; voffB[i] = (unsigned)(Rb * K + C) * 2u; }
    const size_t kstep = (size_t)(BK * 2);
    const size_t hstep = (size_t)HALF * K * 2;
    const size_t tstep = 2 * hstep;
    const unsigned ldsw = (unsigned)wid * 1024u;
    const int aoff = lds_byte(wr * 64 + fr, fq * 8), boff = lds_byte(wc * 32 + fr, fq * 8);
#define PG8_SA(b, h) (((b) * 2 + (h)) * HTB)
#define PG8_SB(b, h) ((4 + (b) * 2 + (h)) * HTB)
#define PG8_STAGE(bufoff, gbase, voff) do { _Pragma("unroll") for (int _i = 0; _i < 2; ++_i) \
        __builtin_amdgcn_global_load_lds((const unsigned*)((const char*)(gbase) + (voff)[_i]), (PG8_LAS unsigned*)(lds + (bufoff) + ldsw + _i * 8192), 16, 0, 0); } while (0)
#define PG8_LDA(dst, b, h) do { _Pragma("unroll") for (int m = 0; m < 4; ++m) _Pragma("unroll") for (int k = 0; k < 2; ++k) dst[m][k] = *(const PG8_LAS bf16x8*)(lds + PG8_SA(b, h) + aoff + m * 2048 + k * 1024); } while (0)
#define PG8_LDB(dst, b, h) do { _Pragma("unroll") for (int n = 0; n < 2; ++n) _Pragma("unroll") for (int k = 0; k < 2; ++k) dst[n][k] = *(const PG8_LAS bf16x8*)(lds + PG8_SB(b, h) + boff + n * 2048 + k * 1024); } while (0)
#define PG8_MMA(ai, bj, At, Bt) do { __builtin_amdgcn_s_setprio(1); _Pragma("unroll") for (int m = 0; m < 4; ++m) _Pragma("unroll") for (int n = 0; n < 2; ++n) _Pragma("unroll") for (int k = 0; k < 2; ++k) \
        acc[ai][bj][m][n] = __builtin_amdgcn_mfma_f32_16x16x32_bf16(Bt[n][k], At[m][k], acc[ai][bj][m][n], 0, 0, 0); __builtin_amdgcn_s_setprio(0); } while (0)
#define PG8_WAIT_V(n) asm volatile("s_waitcnt vmcnt(" #n ")" ::: "memory")
#define PG8_WAIT_L(n) asm volatile("s_waitcnt lgkmcnt(" #n ")" ::: "memory")
#define PG8_BAR __builtin_amdgcn_s_barrier()
#define PG8_SCHED __builtin_amdgcn_sched_barrier(0)
    Unit cur, nxt; int ui = 0;
    if (!S.next(0, cur)) return;
    f32x4 acc[2][2][4][2];
#pragma unroll
    for (int a = 0; a < 2; ++a)
#pragma unroll
        for (int b = 0; b < 2; ++b)
#pragma unroll
            for (int m = 0; m < 4; ++m)
#pragma unroll
                for (int n = 0; n < 2; ++n) acc[a][b][m][n] = (f32x4){0.f, 0.f, 0.f, 0.f};
    bf16x8 At[4][2], B0[2][2], B1[2][2];
    const char* cA = (const char*)g.A + (size_t)cur.pm * tstep; const char* cB = (const char*)g.Bt + (size_t)cur.bt * tstep;
    S.a_ready(cur);
    if constexpr (SP2) {
        PG8_STAGE(PG8_SB(0, 0), cB, voffB); PG8_STAGE(PG8_SB(0, 1), cB + hstep, voffB); PG8_STAGE(PG8_SA(0, 0), cA, voffA); PG8_STAGE(PG8_SA(0, 1), cA + hstep, voffA);
        if (wr == 1) PG8_BAR;
        PG8_WAIT_V(2); PG8_BAR;
        PG8_STAGE(PG8_SB(1, 0), cB + kstep, voffB); PG8_STAGE(PG8_SA(1, 0), cA + kstep, voffA); PG8_STAGE(PG8_SB(1, 1), cB + hstep + kstep, voffB);
        PG8_WAIT_V(6); PG8_BAR;
    } else {
        PG8_STAGE(PG8_SB(0, 0), cB, voffB); PG8_STAGE(PG8_SA(0, 0), cA, voffA); PG8_STAGE(PG8_SB(0, 1), cB + hstep, voffB); PG8_STAGE(PG8_SA(0, 1), cA + hstep, voffA);
        if (wr == 1) PG8_BAR;
        PG8_WAIT_V(4); PG8_BAR;
        PG8_STAGE(PG8_SB(1, 0), cB + kstep, voffB); PG8_STAGE(PG8_SA(1, 0), cA + kstep, voffA); PG8_STAGE(PG8_SB(1, 1), cB + hstep + kstep, voffB);
        PG8_WAIT_V(6); PG8_BAR;
    }
    for (;;) {
        const bool has_next = S.next(ui + 1, nxt);
        const char* nA = has_next ? (const char*)g.A + (size_t)nxt.pm * tstep : cA; const char* nB = has_next ? (const char*)g.Bt + (size_t)nxt.bt * tstep : cB;
        for (int t = 0; t < nt; t += 2) {
            const bool last = (t == nt - 2);
            const char* a1 = cA + (size_t)(t + 1) * kstep;
            const char* a2 = last ? nA : cA + (size_t)(t + 2) * kstep; const char* b2 = last ? nB : cB + (size_t)(t + 2) * kstep;
            const char* a3 = a2 + kstep; const char* b3 = b2 + kstep;
            if (last && has_next) S.a_ready(nxt);
            if constexpr (SP2) {
            PG8_LDB(B0, 0, 0); PG8_LDB(B1, 0, 1); PG8_SCHED; PG8_LDA(At, 0, 0); PG8_STAGE(PG8_SA(1, 1), a1 + hstep, voffA);
            PG8_WAIT_V(8); PG8_WAIT_L(0); PG8_BAR; PG8_MMA(0, 0, At, B0); PG8_MMA(0, 1, At, B1); PG8_BAR; PG8_SCHED;
            PG8_LDA(At, 0, 1); PG8_STAGE(PG8_SB(0, 0), b2, voffB); PG8_STAGE(PG8_SB(0, 1), b2 + hstep, voffB); PG8_STAGE(PG8_SA(0, 0), a2, voffA);
            PG8_WAIT_V(8); PG8_WAIT_L(0); PG8_BAR; PG8_MMA(1, 0, At, B0); PG8_MMA(1, 1, At, B1); PG8_BAR; PG8_SCHED;
            PG8_LDB(B0, 1, 0); PG8_LDB(B1, 1, 1); PG8_SCHED; PG8_LDA(At, 1, 0); PG8_STAGE(PG8_SA(0, 1), a2 + hstep, voffA);
            PG8_WAIT_V(8); PG8_WAIT_L(0); PG8_BAR; PG8_MMA(0, 0, At, B0); PG8_MMA(0, 1, At, B1); PG8_BAR; PG8_SCHED;
            PG8_LDA(At, 1, 1); PG8_STAGE(PG8_SB(1, 0), b3, voffB); PG8_STAGE(PG8_SB(1, 1), b3 + hstep, voffB); PG8_STAGE(PG8_SA(1, 0), a3, voffA);
            PG8_WAIT_V(8); PG8_WAIT_L(0); PG8_BAR; PG8_MMA(1, 0, At, B0); PG8_MMA(1, 1, At, B1); PG8_BAR; PG8_SCHED;
            } else {
            PG8_LDB(B0, 0, 0); PG8_SCHED; PG8_LDA(At, 0, 0); PG8_STAGE(PG8_SA(1, 1), a1 + hstep, voffA);
            PG8_WAIT_L(8); PG8_BAR; PG8_WAIT_L(0); PG8_MMA(0, 0, At, B0); PG8_BAR; PG8_SCHED;
            PG8_LDB(B1, 0, 1); PG8_STAGE(PG8_SB(0, 0), b2, voffB);
            PG8_BAR; PG8_WAIT_L(0); PG8_MMA(0, 1, At, B1); PG8_BAR;
            PG8_LDA(At, 0, 1); PG8_STAGE(PG8_SA(0, 0), a2, voffA);
            PG8_BAR; PG8_WAIT_L(0); PG8_MMA(1, 0, At, B0); PG8_BAR; PG8_SCHED;
            PG8_STAGE(PG8_SB(0, 1), b2 + hstep, voffB);
            PG8_WAIT_V(6); PG8_BAR; PG8_MMA(1, 1, At, B1); PG8_BAR;
            PG8_LDB(B0, 1, 0); PG8_SCHED; PG8_LDA(At, 1, 0); PG8_STAGE(PG8_SA(0, 1), a2 + hstep, voffA);
            PG8_WAIT_L(8); PG8_BAR; PG8_WAIT_L(0); PG8_MMA(0, 0, At, B0); PG8_BAR; PG8_SCHED;
            PG8_LDB(B1, 1, 1); PG8_STAGE(PG8_SB(1, 0), b3, voffB);
            PG8_BAR; PG8_WAIT_L(0); PG8_MMA(0, 1, At, B1); PG8_BAR;
            PG8_LDA(At, 1, 1); PG8_STAGE(PG8_SA(1, 0), a3, voffA);
            PG8_BAR; PG8_WAIT_L(0); PG8_MMA(1, 0, At, B0); PG8_BAR; PG8_SCHED;
            PG8_STAGE(PG8_SB(1, 1), b3 + hstep, voffB);
            PG8_WAIT_V(6); PG8_BAR; PG8_MMA(1, 1, At, B1); PG8_BAR;
            }
        }
        if constexpr (ALIGN_EPI) { if (wr == 0) PG8_BAR; }
        if constexpr (!Epi::AFTER_DRAIN) { E(acc, cur, wr, wc, fr, fq); S.done(cur); }
        if (!has_next) break;
#pragma unroll
        for (int a = 0; a < 2; ++a)
#pragma unroll
            for (int b = 0; b < 2; ++b)
#pragma unroll
                for (int m = 0; m < 4; ++m)
#pragma unroll
                    for (int n = 0; n < 2; ++n) acc[a][b][m][n] = (f32x4){0.f, 0.f, 0.f, 0.f};
        cur = nxt; cA = nA; cB = nB; ++ui;
        if constexpr (ALIGN_EPI) { if (wr == 1) PG8_BAR; }
    }
    PG8_WAIT_V(0);
    if constexpr (!ALIGN_EPI) { if (wr == 0) PG8_BAR; }
    PG8_BAR;
    if constexpr (Epi::AFTER_DRAIN) { E.fused(acc, cur, wr, wc, fr, fq, lds, wid, lane); S.done(cur); }
#undef PG8_SA
#undef PG8_SB
#undef PG8_STAGE
#undef PG8_LDA
#undef PG8_LDB
#undef PG8_MMA
#undef PG8_WAIT_V
#undef PG8_WAIT_L
#undef PG8_BAR
#undef PG8_SCHED
}
}
#include <hip/hip_bf16.h>
#include <cmath>
namespace attn_body {
using bf16=__hip_bfloat16;
using bf16x8=__attribute__((ext_vector_type(8)))short;
using s16x4=__attribute__((ext_vector_type(4)))short;
using f32x16=__attribute__((ext_vector_type(16)))float;
using u32x4=__attribute__((ext_vector_type(4)))unsigned;
constexpr int BATCH=4,NHEAD=8,SEQ=4096,D=64,DM=NHEAD*D,OPITCH=1024,OOFF=512;
constexpr int NW=8,QBLK=32,QB=QBLK*NW,KVBLK=64,NQB=SEQ/QB;
constexpr int ATTN_PITCH=DM, ATTN_UNIT_ROWS=QB;
__device__ __forceinline__ int crow(int r,int hi){return (r&3)+8*(r>>2)+4*hi;}
#define SBAR() __builtin_amdgcn_sched_barrier(0)
__device__ __forceinline__ void cmask(f32x16&p0,f32x16&p1,int jb,int qrel,int hi){
  const float NEG=-INFINITY; const int lim=qrel-64*jb-4*hi;
  #pragma unroll
  for(int r=0;r<16;++r){const int kc=(r&3)+8*(r>>2); if(kc>lim)p0[r]=NEG; if(kc+32>lim)p1[r]=NEG;}
}

__device__ __forceinline__ void smask(f32x16&p0,f32x16&p1,bool sel){
  const float NEG=-INFINITY;
  if(!sel){
    #pragma unroll
    for(int r=0;r<16;++r){p0[r]=NEG;p1[r]=NEG;} }
}
constexpr int NSLOT=3, SLOTB=8192;
constexpr int LDS_K=0, LDS_V=NSLOT*SLOTB, LDS_WS=2*NSLOT*SLOTB, LDS_OST=LDS_WS+NW*64*4, LDS_BYTES=LDS_OST+NW*4096;
constexpr float C2=0.125f*1.4426950408889634f;
__device__ __forceinline__ void glds16(const void*gsrc,unsigned lds_dst){unsigned keep;
  asm volatile("s_mov_b32 %0, m0\n\ts_mov_b32 m0, %2\n\ts_nop 0\n\tglobal_load_lds_dwordx4 %1, off\n\ts_mov_b32 m0, %0":"=&s"(keep):"v"(gsrc),"s"(lds_dst):"memory");}
__device__ __forceinline__ float max3f(float a,float b,float c){float r;asm("v_max3_f32 %0, %1, %2, %3":"=v"(r):"v"(a),"v"(b),"v"(c));return r;}
__device__ __forceinline__ float max2f(float a,float b){float r;asm("v_max_f32_e32 %0, %1, %2":"=v"(r):"v"(a),"v"(b));return r;}
__device__ __forceinline__ float fadd_s(float a,float b){float r;asm("v_add_f32_e32 %0, %1, %2":"=v"(r):"v"(a),"v"(b));return r;}
__device__ __forceinline__ float fsub_s(float a,float b){float r;asm("v_sub_f32_e32 %0, %1, %2":"=v"(r):"v"(a),"v"(b));return r;}
typedef float f32x2_t __attribute__((ext_vector_type(2))); typedef __bf16 bf16x2_t __attribute__((ext_vector_type(2)));
__device__ __forceinline__ unsigned cvtpk_s(float lo,float hi){f32x2_t v={lo,hi};bf16x2_t b=__builtin_convertvector(v,bf16x2_t);return __builtin_bit_cast(unsigned,b);}
#define WAIT_BAR(N) asm volatile("s_waitcnt vmcnt(" #N ") lgkmcnt(0)\n\ts_barrier":::"memory")

__device__ __forceinline__ void qkt(f32x16&p0,f32x16&p1,const char*Kslot,const bf16x8*qr,const f32x16&negm,int r32,int hi){
  const char*kb=Kslot+hi*1024+r32*16;
  #pragma unroll
  for(int d0=0;d0<4;++d0){
    const bf16x8 b0=*reinterpret_cast<const bf16x8*>(kb+d0*2048);
    const bf16x8 b1=*reinterpret_cast<const bf16x8*>(kb+d0*2048+512);
    if(d0==0){p0=__builtin_amdgcn_mfma_f32_32x32x16_bf16(b0,qr[0],negm,0,0,0);p1=__builtin_amdgcn_mfma_f32_32x32x16_bf16(b1,qr[0],negm,0,0,0);}
    else{p0=__builtin_amdgcn_mfma_f32_32x32x16_bf16(b0,qr[d0],p0,0,0,0);p1=__builtin_amdgcn_mfma_f32_32x32x16_bf16(b1,qr[d0],p1,0,0,0);}}
}
typedef __attribute__((address_space(3))) const char* lds_cptr;
typedef short v4i16_t __attribute__((ext_vector_type(4)));
__device__ __forceinline__ void kload8(bf16x8*kf,lds_cptr kp){
  kf[0]=*(const __attribute__((address_space(3))) bf16x8*)(kp);      kf[1]=*(const __attribute__((address_space(3))) bf16x8*)(kp+512);
  kf[2]=*(const __attribute__((address_space(3))) bf16x8*)(kp+2048); kf[3]=*(const __attribute__((address_space(3))) bf16x8*)(kp+2560);
  kf[4]=*(const __attribute__((address_space(3))) bf16x8*)(kp+4096); kf[5]=*(const __attribute__((address_space(3))) bf16x8*)(kp+4608);
  kf[6]=*(const __attribute__((address_space(3))) bf16x8*)(kp+6144); kf[7]=*(const __attribute__((address_space(3))) bf16x8*)(kp+6656);
}
__device__ __forceinline__ void kload2(bf16x8*kf,lds_cptr kp,int j){ kf[2*j]=*(const __attribute__((address_space(3))) bf16x8*)(kp+j*2048); kf[2*j+1]=*(const __attribute__((address_space(3))) bf16x8*)(kp+j*2048+512); }
__device__ __forceinline__ s16x4 vtr(lds_cptr p){ return __builtin_bit_cast(s16x4,__builtin_amdgcn_ds_read_tr16_b64_v4i16((__attribute__((address_space(3))) v4i16_t*)p)); }
__device__ __forceinline__ float rowmax(const f32x16&p0,const f32x16&p1){
  float a=max3f(p0[0],p0[1],p1[0]),b=max3f(p0[2],p0[3],p1[1]);a=max3f(a,p1[2],p1[3]);
  #pragma unroll
  for(int r=4;r<16;r+=4){a=max3f(a,p0[r],p0[r+1]);b=max3f(b,p0[r+2],p0[r+3]);a=max3f(a,p1[r],p1[r+1]);b=max3f(b,p1[r+2],p1[r+3]);}
  const float m=max2f(a,b);
  auto rr=__builtin_amdgcn_permlane32_swap(__float_as_uint(m),__float_as_uint(m),false,false);
  return max2f(__uint_as_float(rr[0]),__uint_as_float(rr[1]));
}
__device__ __forceinline__ void pv(f32x16*o,int vb,bf16x8 pa0,bf16x8 pa1,bf16x8 pa2,bf16x8 pa3){
  #pragma unroll
  for(int d0=0;d0<2;++d0){s16x4 lo[4],hi[4];
    #pragma unroll
    for(int ks=0;ks<4;++ks){
      asm volatile("ds_read_b64_tr_b16 %0,%1 offset:%c2":"=&v"(lo[ks]):"v"(vb),"i"(d0*4096+ks*1024):"memory");
      asm volatile("ds_read_b64_tr_b16 %0,%1 offset:%c2":"=&v"(hi[ks]):"v"(vb),"i"(d0*4096+ks*1024+512):"memory");}
    asm volatile("s_waitcnt lgkmcnt(0)":::"memory");SBAR();
    #define PK(k) (bf16x8){lo[k][0],lo[k][1],lo[k][2],lo[k][3],hi[k][0],hi[k][1],hi[k][2],hi[k][3]}
    o[d0]=__builtin_amdgcn_mfma_f32_32x32x16_bf16(pa0,PK(0),o[d0],0,0,0);
    o[d0]=__builtin_amdgcn_mfma_f32_32x32x16_bf16(pa1,PK(1),o[d0],0,0,0);
    o[d0]=__builtin_amdgcn_mfma_f32_32x32x16_bf16(pa2,PK(2),o[d0],0,0,0);
    o[d0]=__builtin_amdgcn_mfma_f32_32x32x16_bf16(pa3,PK(3),o[d0],0,0,0);
    #undef PK
  }
}

#ifndef ATTN_STORE16
#define ATTN_STORE16(p,v) (*(u32x4*)(p)=(v))
#endif
template<int THRL> __device__ __forceinline__ void attn_unit(int b,int h,int qb,const bf16*Q,const bf16*__restrict__ K,const bf16*__restrict__ V,bf16*O,const float*__restrict__ kpart,char*shm){
  const int tid=ltid(),lane=tid&63,r32=lane&31,hi=lane>>5; const int wid=__builtin_amdgcn_readfirstlane(tid>>6);
  const long rowbase=(long)b*SEQ; const int q0=qb*QB;
  const bf16*Qw=Q+(rowbase+q0+wid*QBLK)*DM+h*D;
  const bf16*Kh=K+rowbase*DM+h*D,*Vh=V+rowbase*DM+h*D;
  const unsigned lds0=(unsigned)(uintptr_t)shm;
  float*wsf=(float*)(shm+LDS_WS)+wid*64;
  const bf16*ksrc=Kh+(long)lane*DM+wid*8;
  const bf16*vsrc=Vh+(long)(16*(wid&3)+(lane>>2))*DM+(wid>>2)*32+(lane&3)*8;
  const unsigned kdst=lds0+LDS_K+wid*1024, vdst=lds0+LDS_V+wid*1024;
  #define KT(t) (((t)<4)?(NT-4+(t)):((t)-4))
  #define DMA_K(t,slot) glds16(ksrc+(long)KT(t)*KVBLK*DM,(unsigned)__builtin_amdgcn_readfirstlane(kdst+(slot)))
  #define DMA_V(t,slot) glds16(vsrc+(long)KT(t)*KVBLK*DM,(unsigned)__builtin_amdgcn_readfirstlane(vdst+(slot)))
  const int vb0=(int)(lds0+LDS_V)+((lane>>4)&1)*32+(lane&3)*8+(4*hi+((lane&15)>>2))*64;
  const char*Kbase=shm+LDS_K; bf16x8 kf[8];
  const lds_cptr shm3=(lds_cptr)shm; const lds_cptr kp0=shm3+LDS_K+hi*1024+r32*16; const lds_cptr vp0=shm3+LDS_V+((lane>>4)&1)*32+(lane&3)*8+(4*hi+((lane&15)>>2))*64;
  const int NT=(q0+QB)/KVBLK;
  DMA_K(0,0);DMA_V(0,0);DMA_K(1,SLOTB);
  bf16x8 qr[4];
  #pragma unroll
  for(int d0=0;d0<4;++d0)qr[d0]=*reinterpret_cast<const bf16x8*>(&Qw[(long)r32*DM+d0*16+hi*8]);
  __attribute__((address_space(3))) unsigned*selw=(__attribute__((address_space(3))) unsigned*)(__attribute__((address_space(3))) char*)(shm3+LDS_BYTES+4096);
  { float*km=(float*)(shm+LDS_BYTES);
    for(int i=tid;i<qb*64;i+=NW*64){ const int n=i>>6,d=i&63; const float*kp=kpart+((long)(b*(SEQ/32)+n*8))*DM+h*D+d; float s=0.f;
      #pragma unroll
      for(int k=0;k<8;++k)s+=kp[(long)k*DM];
      km[i]=s; }
    WAIT_BAR(0);
    float qf[32];
    #pragma unroll
    for(int d0=0;d0<4;++d0){
      #pragma unroll
      for(int j=0;j<8;++j)qf[8*d0+j]=__uint_as_float(((unsigned)(unsigned short)qr[d0][j])<<16); }
    int s0=-1,s1=-1,s2=-1; float g0=-INFINITY,g1=-INFINITY,g2=-INFINITY;
    for(int n=0;n<qb;++n){ const float*kr=km+n*64+8*hi; float g=0.f;
      #pragma unroll
      for(int d0=0;d0<4;++d0){
        #pragma unroll
        for(int j=0;j<8;++j)g+=qf[8*d0+j]*kr[16*d0+j]; }
      { auto rr=__builtin_amdgcn_permlane32_swap(__float_as_uint(g),__float_as_uint(g),false,false); g=__uint_as_float(rr[0])+__uint_as_float(rr[1]); }
      if(g>g0){g2=g1;s2=s1;g1=g0;s1=s0;g0=g;s0=n;} else if(g>g1){g2=g1;s2=s1;g1=g;s1=n;} else if(g>g2){g2=g;s2=n;} }
    selw[tid]=(s0>=0?1u<<s0:0u)|(s1>=0?1u<<s1:0u)|(s2>=0?1u<<s2:0u);
  }
  float mhat=0.f,l_reg=0.f;f32x16 o[2];o[0]=f32x16{};o[1]=f32x16{};f32x16 negm=f32x16{};asm volatile("":"+v"(negm));
  const int qrel=wid*QBLK+r32;
  #define CMASK(P0,P1,t) do{const int t_=(t); if(t_<4)cmask(P0,P1,t_,qrel,hi);}while(0)
  #define SELF(tt) ((((tt)<4)||((selw[tid]>>(((tt)-4)>>2))&1u))?0.f:-INFINITY)
  #define BLKMASK(t) do{const int t_=(t); if(t_>=4&&(t_&3)==0){const float ma_=SELF(t_); _Pragma("unroll") for(int r=0;r<16;++r)negm[r]=ma_-mhat; asm volatile("":"+v"(negm));}}while(0)
  bool resc=false;
  #define START(P0,P1) do{ const float rm=rowmax(P0,P1); resc=false; \
    { const float dl=rm; mhat=fadd_s(mhat,dl); \
      _Pragma("unroll") for(int r=0;r<16;++r){P0[r]=fsub_s(P0[r],dl);P1[r]=fsub_s(P1[r],dl);} \
      _Pragma("unroll") for(int r=0;r<16;++r)negm[r]=-mhat; asm volatile("":"+v"(negm)); } \
    _Pragma("unroll") for(int r=0;r<16;++r)P0[r]=__builtin_amdgcn_exp2f(P0[r]); }while(0)
  #define RESC() do{ if(resc){ asm volatile("s_waitcnt lgkmcnt(0)":::"memory"); \
      _Pragma("unroll") for(int d_=0;d_<2;++d_) _Pragma("unroll") for(int r=0;r<16;++r)o[d_][r]*=wsf[crow(r,hi)]; } }while(0)
  f32x16 pA0,pA1,pB0,pB1;
  int sl_prev=0,sl_cur=0,sl_next=SLOTB;
  #define ROT() do{sl_prev=sl_cur;sl_cur=sl_next;sl_next=(sl_next==(NSLOT-1)*SLOTB)?0:sl_next+SLOTB;}while(0)
  DMA_K(2,2*SLOTB);
  WAIT_BAR(3);
  qkt(pA0,pA1,Kbase,qr,negm,r32,hi);asm volatile("s_nop 15\n\ts_nop 7":"+v"(pA0),"+v"(pA1));CMASK(pA0,pA1,0);
  START(pA0,pA1);
  _Pragma("unroll") for(int r=0;r<16;++r)pA1[r]=__builtin_amdgcn_exp2f(pA1[r]);
  WAIT_BAR(0);
  DMA_K(3,0);DMA_V(1,SLOTB);
  ROT();
  kload8(kf,kp0+sl_cur);
  WAIT_BAR(2);
  s16x4 vlo[8],vhi[8]; u32x4 pw0,pw1,pw2,pw3;
  #define PKW(P,B) cvtpk_s(P[B],P[B+1])
  #define PAF(k) __builtin_bit_cast(bf16x8,pw##k)
  #define VFR(i) (bf16x8){vlo[i][0],vlo[i][1],vlo[i][2],vlo[i][3],vhi[i][0],vhi[i][1],vhi[i][2],vhi[i][3]}
  #define PIN(x) asm volatile("":"+v"(x))
  #define MX3(a,b,c) __builtin_fmaxf(__builtin_fmaxf((a),(b)),(c))
  #define GAPA(MF,A0,A1,A2,A3,W0,W1,PW) do{ MF; sacc+=A0; sacc+=A1; sacc+=A2; sacc+=A3; PIN(sacc); W0; W1; PIN(PW); SBAR(); }while(0)
  #define EX(v) __builtin_amdgcn_exp2f(v)
  #define GAPB(MF,X,B) do{ MF; X[B]=EX(X[B]); X[B+1]=EX(X[B+1]); X[B+2]=EX(X[B+2]); X[B+3]=EX(X[B+3]); PIN(X); SBAR(); }while(0)
  #define VRD(i) do{ vlo[i]=vtr(vp_+(((i)>>2)*4096+((i)&3)*1024)); vhi[i]=vtr(vp_+(((i)>>2)*4096+((i)&3)*1024+512)); }while(0)
  #define KRD(G,j) do{ if(G){ kload2(kf,kp0+sl_next,j); SBAR(); } }while(0)
  #define STEP(C0,C1,P0,P1,t,GK,GV,GL) do{ SBAR(); BLKMASK(t); SBAR(); \
    const lds_cptr vp_=vp0+sl_prev; \
    VRD(0); SBAR(); float sacc=(P0[0]+P0[1]); \
    GAPA(C0=__builtin_amdgcn_mfma_f32_32x32x16_bf16(kf[0],qr[0],negm,0,0,0), P0[2],P0[3],P0[4],P0[5],     pw0[0]=PKW(P0,0), pw0[1]=PKW(P0,2), pw0); \
    VRD(4); SBAR(); GAPA(C1=__builtin_amdgcn_mfma_f32_32x32x16_bf16(kf[1],qr[0],negm,0,0,0), P0[6],P0[7],P0[8],P0[9],     pw0[2]=PKW(P0,4), pw0[3]=PKW(P0,6), pw0); \
    VRD(1); SBAR(); GAPA(C0=__builtin_amdgcn_mfma_f32_32x32x16_bf16(kf[2],qr[1],C0,0,0,0),   P0[10],P0[11],P0[12],P0[13], pw1[0]=PKW(P0,8), pw1[1]=PKW(P0,10), pw1); \
    VRD(5); SBAR(); GAPA(C1=__builtin_amdgcn_mfma_f32_32x32x16_bf16(kf[3],qr[1],C1,0,0,0),   P0[14],P0[15],P1[0],P1[1],   pw1[2]=PKW(P0,12),pw1[3]=PKW(P0,14), pw1); \
    VRD(2); SBAR(); GAPA(C0=__builtin_amdgcn_mfma_f32_32x32x16_bf16(kf[4],qr[2],C0,0,0,0),   P1[2],P1[3],P1[4],P1[5],     pw2[0]=PKW(P1,0), pw2[1]=PKW(P1,2), pw2); \
    VRD(6); SBAR(); GAPA(C1=__builtin_amdgcn_mfma_f32_32x32x16_bf16(kf[5],qr[2],C1,0,0,0),   P1[6],P1[7],P1[8],P1[9],     pw2[2]=PKW(P1,4), pw2[3]=PKW(P1,6), pw2); \
    VRD(3); SBAR(); GAPA(C0=__builtin_amdgcn_mfma_f32_32x32x16_bf16(kf[6],qr[3],C0,0,0,0),   P1[10],P1[11],P1[12],P1[13], pw3[0]=PKW(P1,8), pw3[1]=PKW(P1,10), pw3); \
    VRD(7); SBAR(); GAPA(C1=__builtin_amdgcn_mfma_f32_32x32x16_bf16(kf[7],qr[3],C1,0,0,0),   P1[14],P1[15],0.f,0.f,       pw3[2]=PKW(P1,12),pw3[3]=PKW(P1,14), pw3); \
    l_reg+=sacc; \
    if(GK){DMA_K((t)+3,sl_cur);} if(GV){DMA_V((t)+1,sl_next);} \
    CMASK(C0,C1,t); \
    { float a=MX3(C0[0],C0[1],C1[0]),b=MX3(C0[2],C0[3],C1[1]); a=MX3(a,C1[2],C1[3]); \
      _Pragma("unroll") for(int r=4;r<16;r+=4){a=MX3(a,C0[r],C0[r+1]);b=MX3(b,C0[r+2],C0[r+3]);a=MX3(a,C1[r],C1[r+1]);b=MX3(b,C1[r+2],C1[r+3]);} \
      float rm=__builtin_fmaxf(a,b); { auto rr=__builtin_amdgcn_permlane32_swap(__float_as_uint(rm),__float_as_uint(rm),false,false); rm=__builtin_fmaxf(__uint_as_float(rr[0]),__uint_as_float(rr[1])); } \
      resc=false; \
      if(__builtin_expect(__any(rm>(float)THRL),0)){ const float dl=__builtin_fmaxf(rm,0.f); mhat+=dl; \
        _Pragma("unroll") for(int r=0;r<16;++r){C0[r]-=dl;C1[r]-=dl;} \
        { const float ma2_=SELF((t)); _Pragma("unroll") for(int r=0;r<16;++r)negm[r]=ma2_-mhat; } asm volatile("":"+v"(negm)); \
        const float f=__builtin_amdgcn_exp2f(-dl); l_reg*=f; if(hi==0)wsf[r32]=f; resc=true; } } \
    SBAR(); \
    GAPB(o[0]=__builtin_amdgcn_mfma_f32_32x32x16_bf16(PAF(0),VFR(0),o[0],0,0,0), C0,0); \
    GAPB(o[1]=__builtin_amdgcn_mfma_f32_32x32x16_bf16(PAF(0),VFR(4),o[1],0,0,0), C0,4); \
    KRD(GL,0); GAPB(o[0]=__builtin_amdgcn_mfma_f32_32x32x16_bf16(PAF(1),VFR(1),o[0],0,0,0), C0,8); \
    KRD(GL,1); GAPB(o[1]=__builtin_amdgcn_mfma_f32_32x32x16_bf16(PAF(1),VFR(5),o[1],0,0,0), C0,12); \
    KRD(GL,2); GAPB(o[0]=__builtin_amdgcn_mfma_f32_32x32x16_bf16(PAF(2),VFR(2),o[0],0,0,0), C1,0); \
    KRD(GL,3); GAPB(o[1]=__builtin_amdgcn_mfma_f32_32x32x16_bf16(PAF(2),VFR(6),o[1],0,0,0), C1,4); \
    GAPB(o[0]=__builtin_amdgcn_mfma_f32_32x32x16_bf16(PAF(3),VFR(3),o[0],0,0,0), C1,8); \
    GAPB(o[1]=__builtin_amdgcn_mfma_f32_32x32x16_bf16(PAF(3),VFR(7),o[1],0,0,0), C1,12); \
    }while(0)
  int t=1;
  for(;t+5<NT;t+=2){
    STEP(pB0,pB1,pA0,pA1,t,true,true,true);     WAIT_BAR(2); RESC(); ROT();
    STEP(pA0,pA1,pB0,pB1,t+1,true,true,true);   WAIT_BAR(2); RESC(); ROT();
  }
  #define ENDW(tt) do{ if((tt)+3<NT){WAIT_BAR(2);} else if((tt)+2<NT){WAIT_BAR(1);} else {WAIT_BAR(0);} }while(0)
  for(;t+1<NT;t+=2){
    STEP(pB0,pB1,pA0,pA1,t,(t+3<NT),(t+1<NT),(t+1<NT));       ENDW(t);   RESC(); ROT();
    STEP(pA0,pA1,pB0,pB1,t+1,(t+4<NT),(t+2<NT),(t+2<NT));     ENDW(t+1); RESC(); ROT();
  }
  STEP(pB0,pB1,pA0,pA1,NT-1,false,false,false); RESC();
  { float sacc=pB0[0]+pB0[1]; _Pragma("unroll") for(int r=2;r<16;++r)sacc+=pB0[r]; _Pragma("unroll") for(int r=0;r<16;++r)sacc+=pB1[r]; l_reg+=sacc;
    pw0=(u32x4){PKW(pB0,0),PKW(pB0,2),PKW(pB0,4),PKW(pB0,6)};pw1=(u32x4){PKW(pB0,8),PKW(pB0,10),PKW(pB0,12),PKW(pB0,14)};pw2=(u32x4){PKW(pB1,0),PKW(pB1,2),PKW(pB1,4),PKW(pB1,6)};pw3=(u32x4){PKW(pB1,8),PKW(pB1,10),PKW(pB1,12),PKW(pB1,14)};
    SBAR(); pv(o,vb0+sl_cur,PAF(0),PAF(1),PAF(2),PAF(3)); }
  #undef PKW
  #undef PAF
  #undef VFR
  #undef PIN
  #undef MX3
  #undef GAPA
  #undef GAPB
  #undef EX
  #undef VRD
  #undef KRD
  #undef STEP
  #undef ENDW
  {auto rr=__builtin_amdgcn_permlane32_swap(__float_as_uint(l_reg),__float_as_uint(l_reg),false,false);l_reg=__uint_as_float(rr[0])+__uint_as_float(rr[1]);}
  if(hi==0)wsf[32+r32]=l_reg;asm volatile("s_waitcnt lgkmcnt(0)":::"memory");
  float rli[16];
  #pragma unroll
  for(int r=0;r<16;++r)rli[r]=__builtin_amdgcn_rcpf(wsf[32+crow(r,hi)]);
  bf16*Ow=O+(rowbase+q0+wid*QBLK)*OPITCH+OOFF+h*D;
  { bf16*stg=(bf16*)(shm+LDS_OST)+wid*2048;
    #pragma unroll
    for(int r=0;r<16;++r){const int orow=crow(r,hi);
      #pragma unroll
      for(int d0=0;d0<2;++d0)stg[orow*64+d0*32+r32]=__float2bfloat16(o[d0][r]*rli[r]);}
    asm volatile("s_waitcnt lgkmcnt(0)":::"memory");
    #pragma unroll
    for(int i=0;i<4;++i){const int row=i*8+(lane>>3),ch=lane&7; const u32x4 v=*(const u32x4*)(stg+row*64+ch*8); ATTN_STORE16(Ow+(long)row*OPITCH+ch*8,v);} }
  asm volatile("s_waitcnt lgkmcnt(0)\n\ts_barrier":::"memory");
  #undef DMA_K
  #undef KT
  #undef DMA_V
  #undef CMASK
  #undef SELF
  #undef BLKMASK
  #undef START
  #undef RESC
  #undef ROT
}
constexpr int ATTN_LDS_BYTES=LDS_BYTES;
struct AttnTensors { const bf16* Q; const bf16* K; const bf16* V; bf16* O; const float* kpart; };
struct AttnUnit { int bh; int qb; };
struct StaticOrder {
  int vcu,G;
  __device__ __forceinline__ explicit StaticOrder(int grid,int block):vcu((grid%8==0)?(block%8)*(grid/8)+block/8:block),G(grid){}
  __device__ __forceinline__ bool next(int i,AttnUnit&u)const{ const int j=vcu+i*G; if(j>=512)return false; if(j<256){u.bh=j>>3;u.qb=15-(j&7);} else {u.bh=(j-256)>>3;u.qb=(j-256)&7;} return true; }
  __device__ __forceinline__ void a_ready(const AttnUnit&)const{}
  __device__ __forceinline__ void done(const AttnUnit&)const{}
};
template<class Sched,int THRL=8> __device__ __forceinline__ void attn_phase(char*lds,const AttnTensors&T,const Sched&S){
  AttnUnit u;
  for(int i=0;S.next(i,u);++i){ S.a_ready(u); attn_unit<THRL>(u.bh/NHEAD,u.bh%NHEAD,u.qb,T.Q,T.K,T.V,T.O,T.kpart,lds); S.done(u); }
}
#undef SBAR
#undef WAIT_BAR
}
#define GAS __attribute__((address_space(1)))
#define XB_TMO      128
#define XB_XCNT(j)  (256  + 64 * (j))
#define XB_XSUB(j)  (1280 + 64 * (j))
#define XB_XGEN(j)  (2304 + 64 * (j))
#define XB_TOP      3328
#define XB_TOPGEN   3392
#define XCD_BAR_WORDS 3456
#define XB_SPIN_CAP (1u << 18)

__device__ __forceinline__ unsigned xb_ld(unsigned* p)              { return __hip_atomic_load(p, __ATOMIC_RELAXED, __HIP_MEMORY_SCOPE_AGENT); }
__device__ __forceinline__ unsigned xb_add(unsigned* p, unsigned v) { return __hip_atomic_fetch_add(p, v, __ATOMIC_RELAXED, __HIP_MEMORY_SCOPE_AGENT); }
__device__ __forceinline__ unsigned xb_xcc_id() { return (unsigned)__builtin_amdgcn_s_getreg((3 << 11) | 20) & 0xFu; }
#define XB_SPIN(cond, bar) do { unsigned _sp = 0; while (cond) { __builtin_amdgcn_s_sleep(1); \
    if ((++_sp & 255u) == 0u) { if (xb_ld(&(bar)[XB_TMO])) break; if (_sp > XB_SPIN_CAP) { atomicAdd(&(bar)[XB_TMO], 1u); break; } } } } while (0)

struct XcdBarrier {
    unsigned* bar; unsigned x;
    volatile LAS unsigned* st;
};

__device__ __forceinline__ XcdBarrier xcd_barrier_post(unsigned* bar, volatile LAS unsigned* st) {
    XcdBarrier b; b.bar = bar; b.x = xb_xcc_id(); b.st = st;
    if (threadIdx.x == 0) (void)xb_add(&bar[XB_XCNT(b.x)], 1u);
    return b;
}
__device__ __forceinline__ void xcd_barrier_complete(unsigned* bar, unsigned x, unsigned& nloc, unsigned& nx) {
    const unsigned G = gridDim.x * gridDim.y * gridDim.z;
    unsigned sum, cnt, mine, sp = 0u;
    for (;;) {
        sum = 0u; cnt = 0u; mine = 0u;
#pragma unroll
        for (unsigned j = 0; j < 16; ++j) { const unsigned c = xb_ld(&bar[XB_XCNT(j)]); sum += c; cnt += (c > 0u) ? 1u : 0u; mine = (j == x) ? c : mine; }
        if (sum == G) break;
        __builtin_amdgcn_s_sleep(1);
        if ((++sp & 255u) == 0u) { if (xb_ld(&bar[XB_TMO])) break; if (sp > XB_SPIN_CAP) { atomicAdd(&bar[XB_TMO], 1u); break; } }
    }
    nloc = mine > 0u ? mine : 1u; nx = cnt > 0u ? cnt : 1u;
}

__device__ __forceinline__ void xcd_barrier(const XcdBarrier& b) {
    asm volatile("s_waitcnt vmcnt(0)" ::: "memory");
    __syncthreads();
    if (threadIdx.x == 0) {
        unsigned* bar = b.bar;
        __builtin_amdgcn_s_waitcnt(0);
        unsigned nloc = b.st[0], nx = b.st[1];
        if (nloc == 0u) { xcd_barrier_complete(bar, b.x, nloc, nx); b.st[0] = nloc; b.st[1] = nx; }
        const unsigned old = xb_add(&bar[XB_XSUB(b.x)], 1u);
        const unsigned gen = old / nloc;
        if (old + 1u == (gen + 1u) * nloc) {
            __builtin_amdgcn_fence(__ATOMIC_RELEASE, "agent");
            asm volatile("s_waitcnt vmcnt(0)" ::: "memory");
            const unsigned og = xb_add(&bar[XB_TOP], 1u);
            const unsigned tg = og / nx;
            if (og + 1u == (tg + 1u) * nx) xb_add(&bar[XB_TOPGEN], 1u);
            else XB_SPIN(xb_ld(&bar[XB_TOPGEN]) == tg, bar);
            __builtin_amdgcn_fence(__ATOMIC_ACQUIRE, "agent");
            xb_add(&bar[XB_XGEN(b.x)], 1u);
            asm volatile("s_waitcnt vmcnt(0)" ::: "memory");
        } else {
            XB_SPIN(xb_ld(&bar[XB_XGEN(b.x)]) == gen, bar);
            __builtin_amdgcn_fence(__ATOMIC_ACQUIRE, "agent");
            asm volatile("s_waitcnt vmcnt(0)" ::: "memory");
        }
    }
    __syncthreads();
}

constexpr size_t WT_EIN = WS_WSMALL, WT_EOUT = WT_EIN + 4 * MiB, WT_EUP = WT_EOUT + 2 * MiB, WT_EDN = WT_EUP + 11 * MiB, WT_OIN = WT_EDN + 5 * MiB + 512 * KiB, WT_OOUT = WT_OIN + 6 * MiB;
constexpr size_t WT_MUP = WS_WMOE, WT_MDN = WS_WMOE + 112 * MiB;
static_assert(WT_OOUT + 2 * MiB <= WS_WMOE, "small weights");
__device__ __forceinline__ void cvt_item(const float* W, int K, int N, bf16_t* WT, int dst_row0, int k0, int n0, LAS float* scr, int lane) {
    const int rr = lane >> 3, cc = (lane & 7) * 4;
#pragma unroll
    for (int i = 0; i < 8; ++i) { const int kk = 8 * i + rr; const f32x4 v = *(const f32x4*)(W + (size_t)(k0 + kk) * N + n0 + cc); LAS float* s = scr + kk * 33 + cc; s[0] = v.x; s[1] = v.y; s[2] = v.z; s[3] = v.w; }
    asm volatile("s_waitcnt lgkmcnt(0)" ::: "memory");
    const int c = lane & 7;
#pragma unroll
    for (int j = 0; j < 4; ++j) { const int n = (lane >> 3) + 8 * j; const LAS float* s = scr + (8 * c) * 33 + n;
        u32x4 o; o.x = pk2(s[0 * 33], s[1 * 33]); o.y = pk2(s[2 * 33], s[3 * 33]); o.z = pk2(s[4 * 33], s[5 * 33]); o.w = pk2(s[6 * 33], s[7 * 33]);
        *(u32x4*)(WT + (size_t)(dst_row0 + n) * K + k0 + 8 * c) = o; }
    asm volatile("s_waitcnt lgkmcnt(0)" ::: "memory");
}
__device__ __forceinline__ void cvt_matrix_item(const float* W, int K, int N, bf16_t* WT, int mode, int item, LAS float* scr, int lane) {
    const int nblk = N / 32, kb = item / nblk, nb = item % nblk, n0 = 32 * nb;
    const int dst_row0 = mode == 0 ? n0 : ((n0 >> 7) * 256 + (n0 & 127) + 128 * (mode - 1));
    cvt_item(W, K, N, WT, dst_row0, 64 * kb, n0, scr, lane);
}
__device__ __forceinline__ void stage_convert(const P& p, LAS unsigned char* lds) {
    const int tid_ = ltid(), lane = tid_ & 63, wave = __builtin_amdgcn_readfirstlane(tid_ >> 6);
    LAS float* scr = (LAS float*)(lds + wave * 8448);
    const int gw = blockIdx.x * NWAVES + wave, NGW = gridDim.x * NWAVES;
    constexpr int I_EIN = 16 * 64, I_EOUT = 16 * 32, I_EUP = 16 * 88, I_EDN = 44 * 32, I_OIN = 16 * 96, I_OOUT = 16 * 32, I_MUP = 16 * 112, I_MDN = 56 * 32;
    constexpr int NSMALL = I_EIN + I_EOUT + 2 * I_EUP + I_EDN + I_OIN + I_OOUT, NITEMS = NSMALL + 8 * (2 * I_MUP + I_MDN);
    unsigned char* ws = p.ws;
    for (int it = gw; it < NITEMS; it += NGW) {
        int r = it;
        if (r < I_EIN) { cvt_matrix_item(p.inp(E_W_IN), 1024, 2048, (bf16_t*)(ws + WT_EIN), 0, r, scr, lane); continue; } r -= I_EIN;
        if (r < I_EOUT) { cvt_matrix_item(p.inp(E_W_OUT), 1024, 1024, (bf16_t*)(ws + WT_EOUT), 0, r, scr, lane); continue; } r -= I_EOUT;
        if (r < I_EUP) { cvt_matrix_item(p.inp(E_FFN_WG), 1024, FFN, (bf16_t*)(ws + WT_EUP), 1, r, scr, lane); continue; } r -= I_EUP;
        if (r < I_EUP) { cvt_matrix_item(p.inp(E_FFN_WU), 1024, FFN, (bf16_t*)(ws + WT_EUP), 2, r, scr, lane); continue; } r -= I_EUP;
        if (r < I_EDN) { cvt_matrix_item(p.inp(E_FFN_WD), FFN, 1024, (bf16_t*)(ws + WT_EDN), 0, r, scr, lane); continue; } r -= I_EDN;
        if (r < I_OIN) { cvt_matrix_item(p.inp(O_W_IN), 1024, 3072, (bf16_t*)(ws + WT_OIN), 0, r, scr, lane); continue; } r -= I_OIN;
        if (r < I_OOUT) { cvt_matrix_item(p.inp(O_W_OUT), 1024, 1024, (bf16_t*)(ws + WT_OOUT), 0, r, scr, lane); continue; } r -= I_OOUT;
        const int e = r / (2 * I_MUP + I_MDN); r -= e * (2 * I_MUP + I_MDN);
        if (r < I_MUP) { cvt_matrix_item(p.inp(O_MOE_WG) + (size_t)e * 1024 * ED, 1024, ED, (bf16_t*)(ws + WT_MUP) + (size_t)e * 2 * ED * 1024, 1, r, scr, lane); continue; } r -= I_MUP;
        if (r < I_MUP) { cvt_matrix_item(p.inp(O_MOE_WU) + (size_t)e * 1024 * ED, 1024, ED, (bf16_t*)(ws + WT_MUP) + (size_t)e * 2 * ED * 1024, 2, r, scr, lane); continue; } r -= I_MUP;
        cvt_matrix_item(p.inp(O_MOE_WD) + (size_t)e * ED * 1024, ED, 1024, (bf16_t*)(ws + WT_MDN) + (size_t)e * 1024 * ED, 0, r, scr, lane);
    }
}

#ifndef MK_PER_PHASE
#define MK_PER_PHASE 0
#endif
constexpr int N_PHASES = 19;
__global__ void __launch_bounds__(NWAVES * 64, 2) mega_fwd(const P p) {
    extern __shared__ __attribute__((aligned(16))) unsigned char lds_raw[];
    LAS unsigned char* lds = (LAS unsigned char*)lds_raw;
    volatile LAS unsigned* MISC = (volatile LAS unsigned*)(lds + MISC_OFF);
    const int tid = ltid(), G = gridDim.x;
    for (int u = tid; u < (LDS_BYTES - LDSCTL_OFF) / 4; u += NWAVES * 64) ((LAS unsigned*)(lds + LDSCTL_OFF))[u] = 0u;
    __syncthreads();
#if MK_PER_PHASE
    const int lo = p.ph_lo, hi = p.ph_hi;
#else
    constexpr int lo = 0, hi = N_PHASES;
#endif
    const bool use_bar = (hi - lo) > 1;
    unsigned* ctl = (unsigned*)(p.ws + WS_CTL);
    XcdBarrier bar; bar.bar = ctl + CW_BAR; bar.x = 0; bar.st = nullptr;
    if (use_bar) bar = xcd_barrier_post(ctl + CW_BAR, MISC + 8);
#define IN(k) (lo <= (k) && (k) < hi)
#define SEAM(k) do { if (IN(k) && IN((k) + 1)) xcd_barrier(bar); } while (0)
    unsigned char* ws = p.ws;
    bf16_t* XN = (bf16_t*)(ws + WS_R + R_XN); bf16_t* U = (bf16_t*)(ws + WS_R + R_U); bf16_t* Y = (bf16_t*)(ws + WS_R + R_Y); bf16_t* H = (bf16_t*)(ws + WS_R + R_H);
    bf16_t* Xs = (bf16_t*)(ws + WS_XS); bf16_t* Hs = (bf16_t*)(ws + WS_R + R_HS);
    const float* modE = (const float*)(ws + WS_MOD); const float* modO = modE + 4 * 6144;
    const int* info = (const int*)(ws + WS_EXPINFO);
    typedef pg8::EpiBf16<0> EB;

    if (IN(0)) { stage_prep(p, (LAS float*)lds); __syncthreads(); stage_convert(p, lds); } SEAM(0);
    if (IN(1)) stage_norm<false>(p, p.inp(I_X), p.inp(E_NORM_MIX), modE, 0, 1024, XN); SEAM(1);
    if (IN(2)) { pg8::Gemm g{XN, (const bf16_t*)(ws + WT_EIN), T, 2048, DM}; pg8::StaticOrder S; S.init(T, 2048, G, (int)blockIdx.x);
        EB E{U, 2048, nullptr, 0, 0, 1.f}; pg8::gemm_phase<EB, pg8::StaticOrder, true, true>(lds, g, S, E); } SEAM(2);
    if (IN(3)) stage_griffin_local(p, lds); SEAM(3);
    if (IN(4)) stage_mix0_finish(p, lds); SEAM(4);
    if (IN(5)) { pg8::Gemm g{Y, (const bf16_t*)(ws + WT_EOUT), T, DM, DM}; pg8::StaticOrder S; S.init(T, DM, G, (int)blockIdx.x);
        pg8::EpiResid E{p.inp(I_X), p.out, modE + 2048, DM}; pg8::gemm_phase<pg8::EpiResid, pg8::StaticOrder, true, true>(lds, g, S, E); } SEAM(5);
    if (IN(6)) stage_norm<false>(p, p.out, p.inp(E_NORM_FFN), modE, 3072, 4096, XN); SEAM(6);
    if (IN(7)) { pg8::Gemm g{XN, (const bf16_t*)(ws + WT_EUP), T, 2 * FFN, DM}; pg8::StaticOrder S; S.init(T, 2 * FFN, G, (int)blockIdx.x);
        pg8::EpiSwiglu E{H, FFN}; pg8::gemm_phase<pg8::EpiSwiglu, pg8::StaticOrder, true, true>(lds, g, S, E); } SEAM(7);
    if (IN(8)) { pg8::Gemm g{H, (const bf16_t*)(ws + WT_EDN), T, DM, FFN}; pg8::StaticOrder S; S.init(T, DM, G, (int)blockIdx.x);
        pg8::EpiResid E{p.out, p.out, modE + 5120, DM}; pg8::gemm_phase<pg8::EpiResid, pg8::StaticOrder, true, true>(lds, g, S, E); } SEAM(8);
    if (IN(9)) stage_norm<false>(p, p.out, p.inp(O_NORM_MIX), modO, 0, 1024, XN); SEAM(9);
    if (IN(10)) { pg8::Gemm g{XN, (const bf16_t*)(ws + WT_OIN), T, 3072, DM}; pg8::StaticOrder S; S.init(T, 3072, G, (int)blockIdx.x);
        EB E{U, 3072, nullptr, 0, 0, 1.f}; pg8::gemm_phase<EB, pg8::StaticOrder, true, true>(lds, g, S, E); } SEAM(10);
    if (IN(11)) stage_qkpost(p); SEAM(11);
    if (IN(12)) { stage_shortconv(p);
        const attn_body::AttnTensors AT{(const attn_body::bf16*)(ws + WS_R + R_Q), (const attn_body::bf16*)(ws + WS_R + R_K), (const attn_body::bf16*)(ws + WS_R + R_V), (attn_body::bf16*)Y, (const float*)(ws + WS_KPART)};
        const attn_body::StaticOrder S(G, (int)blockIdx.x);
        attn_body::attn_phase<attn_body::StaticOrder>((char*)lds_raw, AT, S); } SEAM(12);
    if (IN(13)) { pg8::Gemm g{Y, (const bf16_t*)(ws + WT_OOUT), T, DM, DM}; pg8::StaticOrder S; S.init(T, DM, G, (int)blockIdx.x);
        pg8::EpiResid E{p.out, p.out, modO + 2048, DM}; pg8::gemm_phase<pg8::EpiResid, pg8::StaticOrder, true, true>(lds, g, S, E); } SEAM(13);
    if (IN(14)) stage_norm<true>(p, p.out, p.inp(O_NORM_FFN), modO, 3072, 4096, XN); SEAM(14);
    if (IN(15)) stage_route_assign(p, (LAS int*)lds); SEAM(15);
    if (IN(16)) { pg8::Gemm g{Xs, (const bf16_t*)(ws + WT_MUP), MAXROWS, 2 * ED, DM}; pg8::GroupedOrder S; S.init(info, 2 * ED, G, (int)blockIdx.x);
        pg8::EpiSwiglu E{Hs, ED}; pg8::gemm_phase<pg8::EpiSwiglu, pg8::GroupedOrder, true, true>(lds, g, S, E); } SEAM(16);
    if (IN(17)) { pg8::Gemm g{Hs, (const bf16_t*)(ws + WT_MDN), MAXROWS, DM, ED}; pg8::GroupedOrder S; S.init(info, DM, G, (int)blockIdx.x);
        EB E{Xs, DM, nullptr, 0, 0, 1.f}; pg8::gemm_phase<EB, pg8::GroupedOrder, true, true>(lds, g, S, E); } SEAM(17);
    if (IN(18)) stage_combine(p);
#undef IN
#undef SEAM
}

extern "C" void kernel_launch(void* const* d_in, const int* in_sizes, int n_in, void* d_out, int out_size, void* d_ws, size_t ws_size, hipStream_t stream) {
    static int grid = 0;
    if (grid == 0) {
        if (n_in != N_IN || ws_size < WS_END || out_size != T * DM) { fprintf(stderr, "kernel_launch: n_in %d ws %zu (need %zu) out %d\n", n_in, ws_size, (size_t)WS_END, out_size); grid = -1; return; }
        int dev = 0, cus = 0, per_cu = 0;
        if (hipGetDevice(&dev) != hipSuccess || hipDeviceGetAttribute(&cus, hipDeviceAttributeMultiprocessorCount, dev) != hipSuccess) { grid = -1; return; }
        if (hipFuncSetAttribute((const void*)mega_fwd, hipFuncAttributeMaxDynamicSharedMemorySize, LDS_BYTES) != hipSuccess) { fprintf(stderr, "kernel_launch: hipFuncSetAttribute failed\n"); grid = -1; return; }
        if (hipOccupancyMaxActiveBlocksPerMultiprocessor(&per_cu, (const void*)mega_fwd, NWAVES * 64, LDS_BYTES) != hipSuccess || per_cu < 1) { fprintf(stderr, "kernel_launch: occupancy query says %d\n", per_cu); (void)hipGetLastError(); grid = -1; return; }
        grid = cus;
    }
    if (grid < 0) return;
    (void)hipMemsetAsync((char*)d_ws + WS_CTL, 0, CTL_BYTES, stream);
    P a{};
    for (int i = 0; i < N_IN; ++i) a.in[i] = (const float*)d_in[i];
    a.out = (float*)d_out; a.ws = (unsigned char*)d_ws;
    if (MK_PER_PHASE) { for (int k = 0; k < N_PHASES; ++k) { a.ph_lo = k; a.ph_hi = k + 1; hipLaunchKernelGGL(mega_fwd, dim3(grid), dim3(NWAVES * 64), LDS_BYTES, stream, a); } }
    else { a.ph_lo = 0; a.ph_hi = N_PHASES; hipLaunchKernelGGL(mega_fwd, dim3(grid), dim3(NWAVES * 64), LDS_BYTES, stream, a); }
}
```

```cpp
#include <hip/hip_runtime.h>
#include <cstdint>
#include <cstdio>

#define LAS __attribute__((address_space(3)))
typedef unsigned short bf16_t;
typedef short bf16x8 __attribute__((ext_vector_type(8)));
typedef float f32x4 __attribute__((ext_vector_type(4)));
typedef unsigned u32x4 __attribute__((ext_vector_type(4)));
typedef unsigned u32x2 __attribute__((ext_vector_type(2)));

constexpr int NB = 4, SEQ = 4096, DM = 1024, T = NB * SEQ;
constexpr int MIXW = 512, FFN = 2816, NE = 8, ED = 3584;
constexpr int MAXROWS = 34816;
constexpr float C2 = 0.125f * 1.4426950408889634f;

enum In { I_X = 0, I_C, E_ADA_W, E_ADA_B, E_NORM_MIX, E_NORM_FFN, E_W_IN, E_CONV_A_W, E_CONV_A_B, E_LN_A_G, E_LN_A_B, E_CONV_B_W, E_CONV_B_B,
          E_LRU_WA, E_LRU_BA, E_LRU_WX, E_LRU_BX, E_LRU_LAMBDA, E_W_OUT, E_FFN_WG, E_FFN_WU, E_FFN_WD,
          O_ADA_W, O_ADA_B, O_NORM_MIX, O_NORM_FFN, O_W_IN, O_CONV_C_W, O_Q_NORM, O_K_NORM, O_W_OUT, O_ROUTER_W, O_ROUTER_B, O_MOE_WG, O_MOE_WU, O_MOE_WD, N_IN };

constexpr size_t KiB = 1024, MiB = 1024 * 1024;
constexpr size_t WS_CTL = 0, CTL_BYTES = 128 * KiB;
constexpr size_t WS_MOD = 128 * KiB;
constexpr size_t WS_ROPE_C = 320 * KiB, WS_ROPE_S = 832 * KiB;
constexpr size_t WS_AAGG = 1344 * KiB, WS_HAGG = 1856 * KiB;
constexpr size_t WS_KPART = 2368 * KiB;
constexpr size_t WS_TOPE = 3392 * KiB, WS_TOPW = 3520 * KiB, WS_POS = 3648 * KiB;
constexpr size_t WS_EXPINFO = 3776 * KiB;
constexpr size_t WS_KMEAN = 3780 * KiB;
constexpr size_t WS_WSMALL = 4 * MiB;
constexpr size_t WS_WMOE = WS_WSMALL + 30 * MiB + 512 * KiB;
constexpr size_t WS_XS = WS_WMOE + 168 * MiB;
constexpr size_t WS_R = WS_XS + 68 * MiB;
constexpr size_t R_U = 0, R_HLP = 96 * MiB, R_Q = 96 * MiB, R_K = 112 * MiB, R_Y = 128 * MiB, R_XN = 160 * MiB, R_V = 192 * MiB, R_H = 0, R_HS = 0;
constexpr size_t WS_END = WS_R + 238 * MiB;

struct P {
    const float* in[N_IN];
    float* out;
    unsigned char* ws;
    int ph_lo, ph_hi;
    __device__ __forceinline__ const float* inp(int i) const {
        unsigned off = (unsigned)i * 8u; asm volatile("" : "+s"(off));
        const __attribute__((address_space(4))) char* ka = (const __attribute__((address_space(4))) char*)__builtin_amdgcn_kernarg_segment_ptr();
        return *(const float* const __attribute__((address_space(4)))*)(ka + off);
    }
};

__device__ __forceinline__ int ltid() { int t = (int)threadIdx.x; asm volatile("" : "+v"(t)); return t; }
__device__ __forceinline__ float bf2f(unsigned v) { return __uint_as_float(v << 16); }
__device__ __forceinline__ unsigned f2bf(float f) { unsigned u = __float_as_uint(f); return (u + 0x7fffu + ((u >> 16) & 1u)) >> 16; }
__device__ __forceinline__ unsigned pk2(float lo, float hi) { return f2bf(lo) | (f2bf(hi) << 16); }
__device__ __forceinline__ float wave_sum(float v) {
#pragma unroll
    for (int o = 1; o < 64; o <<= 1) v += __shfl_xor(v, o);
    return v;
}
__device__ __forceinline__ float sigmoidf_(float x) { return 1.f / (1.f + __expf(-x)); }
__device__ __forceinline__ float gelu_tanh(float x) { const float u = 0.7978845608028654f * (x + 0.044715f * x * x * x); return 0.5f * x * (1.f + tanhf(u)); }

__device__ __forceinline__ void stage_prep(const P& p, LAS float* lf  ) {
    const int tid = ltid(), lane = tid & 63, wave = tid >> 6;
    float* mod = (float*)(p.ws + WS_MOD);
    LAS float* cact = lf; LAS float* red = lf + 4096;
    { const float* cvec = p.inp(I_C); for (int i = tid; i < 4096; i += 512) { const float cv = cvec[i]; cact[i] = cv / (1.f + __expf(-cv)); } }
    __syncthreads();
    for (int chunk = blockIdx.x; chunk < 192; chunk += gridDim.x) {
        const int L = chunk / 96, col0 = (chunk % 96) * 64;
        const float* W = p.inp(L ? O_ADA_W : E_ADA_W); const float* bias = p.inp(L ? O_ADA_B : E_ADA_B);
        float acc[4] = {0.f, 0.f, 0.f, 0.f};
        const int k0 = wave * 128;
#pragma unroll 1
        for (int kb = k0; kb < k0 + 128; kb += 32) {
            float w[32];
#pragma unroll
            for (int i = 0; i < 32; ++i) w[i] = W[(size_t)(kb + i) * 6144 + col0 + lane];
#pragma unroll
            for (int i = 0; i < 32; ++i)
#pragma unroll
                for (int b = 0; b < 4; ++b) acc[b] += cact[b * 1024 + kb + i] * w[i];
        }
#pragma unroll
        for (int b = 0; b < 4; ++b) red[(wave * 4 + b) * 64 + lane] = acc[b];
        __syncthreads();
        if (tid < 256) { const int b = tid >> 6, l = tid & 63; float sacc = bias[col0 + l];
#pragma unroll
            for (int w = 0; w < 8; ++w) sacc += red[(w * 4 + b) * 64 + l];
            mod[(size_t)(L * 4 + b) * 6144 + col0 + l] = sacc; }
        __syncthreads();
    }
    float* rc = (float*)(p.ws + WS_ROPE_C); float* rs = (float*)(p.ws + WS_ROPE_S);
    for (int i = blockIdx.x * blockDim.x + tid; i < SEQ * 32; i += gridDim.x * blockDim.x) {
        const int pos = i >> 5, d = i & 31;
        const double inv = exp(-(double)d * (1.0 / 32.0) * 9.210340371976184);
        const double ang = (double)pos * inv;
        rc[i] = (float)cos(ang); rs[i] = (float)sin(ang);
    }
}

template <bool ROUTE>
__device__ __forceinline__ void stage_norm(const P& p, const float* X, const float* nw, const float* modL, int sh_off, int sc_off, bf16_t* XN) {
    const int tid_ = ltid(), lane = tid_ & 63, wave = tid_ >> 6, nwv = blockDim.x >> 6;
    const int gw = blockIdx.x * nwv + wave, NGW = gridDim.x * nwv;
    f32x4 w4[4];
#pragma unroll
    for (int j = 0; j < 4; ++j) w4[j] = *(const f32x4*)(nw + 4 * lane + 256 * j);
    const float* rw = p.inp(O_ROUTER_W); const float* rb = p.inp(O_ROUTER_B);
    int* tope = (int*)(p.ws + WS_TOPE); float* topw = (float*)(p.ws + WS_TOPW);
    for (int row = gw; row < T; row += NGW) {
        const int b = row >> 12;
        const f32x4* xr = (const f32x4*)(X + (size_t)row * DM) + lane;
        f32x4 v[4]; float ss = 0.f;
#pragma unroll
        for (int j = 0; j < 4; ++j) { v[j] = xr[64 * j]; ss += (v[j].x * v[j].x + v[j].y * v[j].y) + (v[j].z * v[j].z + v[j].w * v[j].w); }
        ss = wave_sum(ss);
        const float rstd = 1.0f / sqrtf(ss * (1.f / DM) + 1e-6f);
        const float* sc = modL + b * 6144 + sc_off; const float* sh = modL + b * 6144 + sh_off;
        float lg[8] = {0.f, 0.f, 0.f, 0.f, 0.f, 0.f, 0.f, 0.f};
#pragma unroll
        for (int j = 0; j < 4; ++j) {
            const f32x4 s4 = *(const f32x4*)(sc + 4 * lane + 256 * j), h4 = *(const f32x4*)(sh + 4 * lane + 256 * j);
            const f32x4 o = (v[j] * rstd) * w4[j] * (s4 + 1.f) + h4;
            u32x2 w; w.x = pk2(o.x, o.y); w.y = pk2(o.z, o.w);
            *(u32x2*)(XN + (size_t)row * DM + 4 * lane + 256 * j) = w;
            if (ROUTE) {
#pragma unroll
                for (int i = 0; i < 4; ++i) { const int k = 4 * lane + 256 * j + i; const f32x4 r0 = *(const f32x4*)(rw + k * 8), r1 = *(const f32x4*)(rw + k * 8 + 4);
                    lg[0] += o[i] * r0.x; lg[1] += o[i] * r0.y; lg[2] += o[i] * r0.z; lg[3] += o[i] * r0.w; lg[4] += o[i] * r1.x; lg[5] += o[i] * r1.y; lg[6] += o[i] * r1.z; lg[7] += o[i] * r1.w; }
            }
        }
        if (ROUTE) {
#pragma unroll
            for (int e = 0; e < 8; ++e) lg[e] = wave_sum(lg[e]) + rb[e];
            int e0 = 0; float l0 = lg[0];
#pragma unroll
            for (int e = 1; e < 8; ++e) if (lg[e] > l0) { l0 = lg[e]; e0 = e; }
            int e1 = -1; float l1 = -INFINITY;
#pragma unroll
            for (int e = 0; e < 8; ++e) if (e != e0 && lg[e] > l1) { l1 = lg[e]; e1 = e; }
            const float w0 = 1.f / (1.f + __expf(l1 - l0));
            if (lane == 0) { tope[row * 2] = e0; tope[row * 2 + 1] = e1; topw[row * 2] = w0; topw[row * 2 + 1] = 1.f - w0; }
        }
    }
}

constexpr int GL_WAVE_LDS = 10752;
__device__ __forceinline__ void stage_griffin_local(const P& p, LAS unsigned char* lds) {
    const int tid = ltid(), lane = tid & 63, wave = __builtin_amdgcn_readfirstlane(tid >> 6);
    LAS unsigned char* wl = lds + wave * GL_WAVE_LDS;
    LAS bf16_t* XA = (LAS bf16_t*)wl;
    LAS float* ZA = (LAS float*)(wl + 2304);
    LAS float* ZX = (LAS float*)(wl + 2304 + 4160);
    const int h = wave, c = 64 * h + lane, fr = lane & 15, fq = lane >> 4;
    const float cw0 = p.inp(E_CONV_B_W)[c], cw1 = p.inp(E_CONV_B_W)[512 + c], cw2 = p.inp(E_CONV_B_W)[1024 + c], cw3 = p.inp(E_CONV_B_W)[1536 + c], cb = p.inp(E_CONV_B_B)[c];
    const float ba = p.inp(E_LRU_BA)[c], bx = p.inp(E_LRU_BX)[c], lam = p.inp(E_LRU_LAMBDA)[c];
    const float lsl = fminf(lam, 0.f) - log1pf(expf(-fabsf(lam)));
    const float c8 = 8.0f * lsl;
    bf16x8 Ba[2][4], Bx[2][4];
    { const float* wa = p.inp(E_LRU_WA) + h * 4096; const float* wx = p.inp(E_LRU_WX) + h * 4096;
#pragma unroll
      for (int ks = 0; ks < 2; ++ks)
#pragma unroll
          for (int nt = 0; nt < 4; ++nt)
#pragma unroll
              for (int jj = 0; jj < 8; ++jj) { const int k = 32 * ks + 8 * fq + jj, n = 16 * nt + fr;
                  Ba[ks][nt][jj] = (short)f2bf(wa[k * 64 + n]); Bx[ks][nt][jj] = (short)f2bf(wx[k * 64 + n]); } }
    const bf16_t* U = (const bf16_t*)(p.ws + WS_R + R_U);
    unsigned* HLP = (unsigned*)(p.ws + WS_R + R_HLP);
    float* Aagg = (float*)(p.ws + WS_AAGG); float* Hagg = (float*)(p.ws + WS_HAGG);
    for (int tl = blockIdx.x; tl < 256; tl += gridDim.x) {
        const int b = tl >> 6, j = tl & 63; const size_t row0 = (size_t)b * SEQ + j * 64;
        float x1 = 0.f, x2 = 0.f, x3 = 0.f;
        if (j != 0) { x1 = bf2f(U[(row0 - 1) * 2048 + 1024 + c]); x2 = bf2f(U[(row0 - 2) * 2048 + 1024 + c]); x3 = bf2f(U[(row0 - 3) * 2048 + 1024 + c]); }
        float hst = 0.f, pc = 1.f;
        for (int mt = 0; mt < 4; ++mt) {
            float xb[16];
#pragma unroll
            for (int r = 0; r < 16; ++r) { const float xn = bf2f(U[(row0 + 16 * mt + r) * 2048 + 1024 + c]);
                xb[r] = cb + cw0 * x3 + cw1 * x2 + cw2 * x1 + cw3 * xn; x3 = x2; x2 = x1; x1 = xn; XA[r * 72 + lane] = (bf16_t)f2bf(xb[r]); }
            const bf16x8 a0 = *(const LAS bf16x8*)((LAS unsigned char*)XA + fr * 144 + fq * 16);
            const bf16x8 a1 = *(const LAS bf16x8*)((LAS unsigned char*)XA + fr * 144 + fq * 16 + 64);
#pragma unroll
            for (int nt = 0; nt < 4; ++nt) {
                f32x4 za = {0.f, 0.f, 0.f, 0.f}, zx = {0.f, 0.f, 0.f, 0.f};
                za = __builtin_amdgcn_mfma_f32_16x16x32_bf16(a0, Ba[0][nt], za, 0, 0, 0); za = __builtin_amdgcn_mfma_f32_16x16x32_bf16(a1, Ba[1][nt], za, 0, 0, 0);
                zx = __builtin_amdgcn_mfma_f32_16x16x32_bf16(a0, Bx[0][nt], zx, 0, 0, 0); zx = __builtin_amdgcn_mfma_f32_16x16x32_bf16(a1, Bx[1][nt], zx, 0, 0, 0);
#pragma unroll
                for (int r4 = 0; r4 < 4; ++r4) { ZA[(4 * fq + r4) * 65 + 16 * nt + fr] = za[r4]; ZX[(4 * fq + r4) * 65 + 16 * nt + fr] = zx[r4]; }
            }
#pragma unroll
            for (int r = 0; r < 16; ++r) {
                const float rg = sigmoidf_(ZA[r * 65 + lane] + ba), ig = sigmoidf_(ZX[r * 65 + lane] + bx);
                const float la = c8 * rg, a = __expf(la), mult = sqrtf(-expm1f(2.f * la));
                hst = a * hst + mult * ig * xb[r]; pc *= a;
                HLP[(row0 + 16 * mt + r) * 512 + c] = f2bf(hst) | (f2bf(pc) << 16);
            }
        }
        Aagg[tl * 512 + c] = pc; Hagg[tl * 512 + c] = hst;
    }
}

constexpr int MF_LDS = 95 * 1024;
__device__ __forceinline__ void stage_mix0_finish(const P& p, LAS unsigned char* lds) {
    const int tid = ltid(), lane = tid & 63, wave = __builtin_amdgcn_readfirstlane(tid >> 6);
    const bf16_t* U = (const bf16_t*)(p.ws + WS_R + R_U);
    const unsigned* HLP = (const unsigned*)(p.ws + WS_R + R_HLP);
    const float* Aagg = (const float*)(p.ws + WS_AAGG); const float* Hagg = (const float*)(p.ws + WS_HAGG);
    bf16_t* Y = (bf16_t*)(p.ws + WS_R + R_Y);
    LAS bf16_t* G = (LAS bf16_t*)lds;
    for (int tl = blockIdx.x; tl < 256; tl += gridDim.x) {
        const int b = tl >> 6, j = tl & 63; const size_t row0 = (size_t)b * SEQ + j * 64;
        for (int idx = tid; idx < 95 * 64; idx += 512) {
            const int rho = idx >> 6, ch8 = (idx & 63) * 8, tpos = j * 64 - 30 + rho;
            u32x4 o = {0u, 0u, 0u, 0u};
            if (tpos >= 0 && rho < 94) { const size_t row = (size_t)b * SEQ + tpos;
                const u32x4 av = *(const u32x4*)(U + row * 2048 + ch8), gv = *(const u32x4*)(U + row * 2048 + 512 + ch8);
#pragma unroll
                for (int i = 0; i < 4; ++i) { const float a0 = bf2f(av[i] & 0xffffu), a1 = bf2f(av[i] >> 16), g0 = bf2f(gv[i] & 0xffffu), g1 = bf2f(gv[i] >> 16);
                    o[i] = pk2(a0 * sigmoidf_(g0), a1 * sigmoidf_(g1)); } }
            *(LAS u32x4*)(G + rho * 512 + ch8) = o;
        }
        { const int c = tid; float carry = 0.f;
          for (int jj = 0; jj < j; ++jj) carry = Aagg[(b * 64 + jj) * 512 + c] * carry + Hagg[(b * 64 + jj) * 512 + c];
#pragma unroll 8
          for (int r = 0; r < 64; ++r) { const size_t row = row0 + r; const unsigned hp = HLP[row * 512 + c];
              const float hv = bf2f(hp & 0xffffu) + bf2f(hp >> 16) * carry; const float g = bf2f(U[row * 2048 + 1536 + c]);
              Y[row * 1024 + 512 + c] = (bf16_t)f2bf(hv * gelu_tanh(g)); } }
        __syncthreads();
        f32x4 res[2][8];
        const float* caw = p.inp(E_CONV_A_W);
#pragma unroll
        for (int ps = 0; ps < 2; ++ps) {
            const int c0 = 256 * ps + 4 * lane;
            const f32x4 bias = *(const f32x4*)(p.inp(E_CONV_A_B) + c0);
#pragma unroll
            for (int o = 0; o < 8; ++o) res[ps][o] = bias;
#pragma unroll 1
            for (int jb = 0; jb < 32; jb += 8) {
                f32x4 wv[8], xw[15];
#pragma unroll
                for (int t = 0; t < 8; ++t) { const int jj = jb + t; wv[t] = *(const f32x4*)(caw + (jj < 30 ? jj : 30) * 512 + c0) * (jj <= 30 ? 1.f : 0.f); }
#pragma unroll
                for (int r = 0; r < 15; ++r) { const u32x2 raw = *(const LAS u32x2*)(G + (8 * wave + jb + r) * 512 + c0);
                    xw[r] = (f32x4){bf2f(raw.x & 0xffffu), bf2f(raw.x >> 16), bf2f(raw.y & 0xffffu), bf2f(raw.y >> 16)}; }
#pragma unroll
                for (int o = 0; o < 8; ++o)
#pragma unroll
                    for (int t = 0; t < 8; ++t) res[ps][o] += wv[t] * xw[o + t];
            }
        }
        { const f32x4 g0 = *(const f32x4*)(p.inp(E_LN_A_G) + 4 * lane), g1 = *(const f32x4*)(p.inp(E_LN_A_G) + 256 + 4 * lane);
          const f32x4 b0 = *(const f32x4*)(p.inp(E_LN_A_B) + 4 * lane), b1 = *(const f32x4*)(p.inp(E_LN_A_B) + 256 + 4 * lane);
#pragma unroll
          for (int o = 0; o < 8; ++o) {
              float s = (res[0][o].x + res[0][o].y) + (res[0][o].z + res[0][o].w) + (res[1][o].x + res[1][o].y) + (res[1][o].z + res[1][o].w);
              const float mean = wave_sum(s) * (1.f / 512.f);
              const f32x4 d0 = res[0][o] - mean, d1 = res[1][o] - mean;
              float q = (d0.x * d0.x + d0.y * d0.y) + (d0.z * d0.z + d0.w * d0.w) + (d1.x * d1.x + d1.y * d1.y) + (d1.z * d1.z + d1.w * d1.w);
              const float rstd = 1.0f / sqrtf(wave_sum(q) * (1.f / 512.f) + 1e-6f);
              f32x4 y0 = d0 * rstd * g0 + b0, y1 = d1 * rstd * g1 + b1;
              const size_t row = row0 + 8 * wave + o;
              u32x2 w0, w1;
              w0.x = pk2(y0.x * sigmoidf_(y0.x), y0.y * sigmoidf_(y0.y)); w0.y = pk2(y0.z * sigmoidf_(y0.z), y0.w * sigmoidf_(y0.w));
              w1.x = pk2(y1.x * sigmoidf_(y1.x), y1.y * sigmoidf_(y1.y)); w1.y = pk2(y1.z * sigmoidf_(y1.z), y1.w * sigmoidf_(y1.w));
              *(u32x2*)(Y + row * 1024 + 4 * lane) = w0; *(u32x2*)(Y + row * 1024 + 256 + 4 * lane) = w1;
          } }
        __syncthreads();
    }
}

__device__ __forceinline__ void stage_qkpost(const P& p, LAS float* lks  ) {
    const int tid = ltid(), lane = tid & 63, wave = tid >> 6;
    const bf16_t* U = (const bf16_t*)(p.ws + WS_R + R_U);
    bf16_t* Q = (bf16_t*)(p.ws + WS_R + R_Q); bf16_t* K = (bf16_t*)(p.ws + WS_R + R_K); bf16_t* V = (bf16_t*)(p.ws + WS_R + R_V);
    float* kpart = (float*)(p.ws + WS_KPART);
    const float* rc = (const float*)(p.ws + WS_ROPE_C); const float* rs = (const float*)(p.ws + WS_ROPE_S);
    const int i8 = lane & 7, dd = 8 * (i8 & 3); const bool hi = i8 >= 4;
    float qn[8], kn[8];
    { const float* qnp = p.inp(O_Q_NORM); const float* knp = p.inp(O_K_NORM);
#pragma unroll
      for (int i = 0; i < 8; ++i) { qn[i] = qnp[8 * i8 + i]; kn[i] = knp[8 * i8 + i]; } }
    for (int chunk = blockIdx.x; chunk < T / 64; chunk += gridDim.x) {
        float ksum[8] = {0.f, 0.f, 0.f, 0.f, 0.f, 0.f, 0.f, 0.f};
#pragma unroll 2
        for (int r = 0; r < 8; ++r) {
            const size_t row = (size_t)chunk * 64 + wave * 8 + r; const int pos = (int)(row & (SEQ - 1));
            const f32x4 c0 = *(const f32x4*)(rc + pos * 32 + dd), c1 = *(const f32x4*)(rc + pos * 32 + dd + 4);
            const f32x4 s0 = *(const f32x4*)(rs + pos * 32 + dd), s1 = *(const f32x4*)(rs + pos * 32 + dd + 4);
            const float cs[8] = {c0.x, c0.y, c0.z, c0.w, c1.x, c1.y, c1.z, c1.w}, sn[8] = {s0.x, s0.y, s0.z, s0.w, s1.x, s1.y, s1.z, s1.w};
#pragma unroll
            for (int which = 0; which < 2; ++which) {
                const u32x4 raw = *(const u32x4*)(U + row * 3072 + 1536 + 512 * which + 8 * lane);
                float v[8];
#pragma unroll
                for (int i = 0; i < 4; ++i) { v[2 * i] = bf2f(raw[i] & 0xffffu); v[2 * i + 1] = bf2f(raw[i] >> 16); }
                float ss = 0.f;
#pragma unroll
                for (int i = 0; i < 8; ++i) ss += v[i] * v[i];
                ss += __shfl_xor(ss, 1); ss += __shfl_xor(ss, 2); ss += __shfl_xor(ss, 4);
                const float rstd = 1.0f / sqrtf(ss * (1.f / 64.f) + 1e-6f);
                float o[8];
#pragma unroll
                for (int i = 0; i < 8; ++i) { v[i] = v[i] * rstd * (which ? kn[i] : qn[i]); }
#pragma unroll
                for (int i = 0; i < 8; ++i) { const float pv = __shfl_xor(v[i], 4); o[i] = hi ? (v[i] * cs[i] + pv * sn[i]) : (v[i] * cs[i] - pv * sn[i]); }
                u32x4 w;
                if (which == 0) {
#pragma unroll
                    for (int i = 0; i < 4; ++i) w[i] = pk2(o[2 * i] * C2, o[2 * i + 1] * C2);
                    *(u32x4*)(Q + row * 512 + 8 * lane) = w;
                } else {
#pragma unroll
                    for (int i = 0; i < 8; ++i) ksum[i] += o[i];
#pragma unroll
                    for (int i = 0; i < 4; ++i) w[i] = pk2(o[2 * i], o[2 * i + 1]);
                    *(u32x4*)(K + row * 512 + 8 * lane) = w;
                }
            }
            *(u32x4*)(V + row * 512 + 8 * lane) = *(const u32x4*)(U + row * 3072 + 2560 + 8 * lane);
        }
#pragma unroll
        for (int i = 0; i < 8; ++i) lks[wave * 512 + 8 * lane + i] = ksum[i];
        __syncthreads();
        { float sacc = 0.f;
#pragma unroll
          for (int w = 0; w < 8; ++w) sacc += lks[w * 512 + tid];
          kpart[(size_t)chunk * 512 + tid] = sacc; }
        __syncthreads();
    }
}

__device__ __forceinline__ void stage_shortconv(const P& p) {
    const bf16_t* U = (const bf16_t*)(p.ws + WS_R + R_U);
    bf16_t* Y = (bf16_t*)(p.ws + WS_R + R_Y);
    const float* cw = p.inp(O_CONV_C_W);
    for (int idx = blockIdx.x * blockDim.x + ltid(); idx < T * 64; idx += gridDim.x * blockDim.x) {
        const size_t row = idx >> 6; const int ch8 = (idx & 63) * 8, pos = (int)(row & (SEQ - 1));
        float acc[8] = {0.f, 0.f, 0.f, 0.f, 0.f, 0.f, 0.f, 0.f};
#pragma unroll
        for (int jj = 0; jj < 3; ++jj) {
            if (pos - 2 + jj < 0) continue;
            const size_t r2 = row - 2 + jj;
            const u32x4 hv = *(const u32x4*)(U + r2 * 3072 + ch8), cv = *(const u32x4*)(U + r2 * 3072 + 1024 + ch8);
            const f32x4 wa = *(const f32x4*)(cw + jj * 512 + ch8), wb = *(const f32x4*)(cw + jj * 512 + ch8 + 4);
            const float w[8] = {wa.x, wa.y, wa.z, wa.w, wb.x, wb.y, wb.z, wb.w};
#pragma unroll
            for (int i = 0; i < 4; ++i) { acc[2 * i] += w[2 * i] * (bf2f(hv[i] & 0xffffu) * bf2f(cv[i] & 0xffffu)); acc[2 * i + 1] += w[2 * i + 1] * (bf2f(hv[i] >> 16) * bf2f(cv[i] >> 16)); }
        }
        const u32x4 bv = *(const u32x4*)(U + row * 3072 + 512 + ch8);
        u32x4 o;
#pragma unroll
        for (int i = 0; i < 4; ++i) o[i] = pk2(acc[2 * i] * bf2f(bv[i] & 0xffffu), acc[2 * i + 1] * bf2f(bv[i] >> 16));
        *(u32x4*)(Y + row * 1024 + ch8) = o;
    }
}

__device__ __forceinline__ void stage_route_assign(const P& p, LAS int* li  ) {
    const int tid = ltid(), lane = tid & 63, wave = tid >> 6;
    const int* tope = (const int*)(p.ws + WS_TOPE); int* posk = (int*)(p.ws + WS_POS); int* info = (int*)(p.ws + WS_EXPINFO);
    const bf16_t* XN = (const bf16_t*)(p.ws + WS_R + R_XN); bf16_t* Xs = (bf16_t*)(p.ws + WS_XS);
    LAS int* tot = li; LAS int* bef = li + 8; LAS int* base = li + 16; LAS int* w0cnt = li + 24; LAS int* lpos = li + 64;
    for (int chunk = blockIdx.x; chunk < 256; chunk += gridDim.x) {
        if (tid < 32) li[tid] = 0;
        __syncthreads();
        int ct[8] = {0, 0, 0, 0, 0, 0, 0, 0}, cb[8] = {0, 0, 0, 0, 0, 0, 0, 0};
        for (int tok = tid; tok < T; tok += 512) {
            const int e0 = tope[tok * 2], e1 = tope[tok * 2 + 1]; const bool before = tok < chunk * 64;
#pragma unroll
            for (int e = 0; e < 8; ++e) {
                ct[e] += __popcll(__ballot(e0 == e)) + __popcll(__ballot(e1 == e));
                cb[e] += __popcll(__ballot(before && e0 == e)) + __popcll(__ballot(before && e1 == e));
            }
        }
        if (lane == 0) {
#pragma unroll
            for (int e = 0; e < 8; ++e) { atomicAdd((int*)&tot[e], ct[e]); atomicAdd((int*)&bef[e], cb[e]); }
        }
        int my_e = -1, rank = 0;
        if (wave < 2) { my_e = tope[chunk * 128 + tid];
#pragma unroll
            for (int e = 0; e < 8; ++e) { const unsigned long long m = __ballot(my_e == e);
                if (my_e == e) rank = __popcll(m & ((1ull << lane) - 1ull));
                if (wave == 0 && lane == 0) w0cnt[e] = __popcll(m); } }
        __syncthreads();
        if (tid == 0) {
            int run = 0; int pst[8], pad[8];
#pragma unroll
            for (int e = 0; e < 8; ++e) { pad[e] = (tot[e] + 255) / 256 * 256; pst[e] = run; run += pad[e]; base[e] = pst[e] + bef[e]; }
            if (chunk == 0) { info[0] = run / 256; info[1] = run;
                for (int blk = 0; blk < run / 256; ++blk) { int ee = 7;
#pragma unroll
                    for (int e = 7; e >= 0; --e) if (blk * 256 < pst[e] + pad[e]) ee = e;
                    info[16 + blk] = ee; } }
        }
        __syncthreads();
        if (wave < 2) { const int ps = base[my_e] + rank + (wave == 1 ? w0cnt[my_e] : 0); posk[chunk * 128 + tid] = ps; lpos[tid] = ps; }
        __syncthreads();
        for (int idx = tid; idx < 128 * 128; idx += 512) { const int a = idx >> 7, ch = idx & 127; const int tok = chunk * 64 + (a >> 1); const int ps = lpos[a];
            *(u32x4*)(Xs + (size_t)ps * 1024 + ch * 8) = *(const u32x4*)(XN + (size_t)tok * 1024 + ch * 8); }
        __syncthreads();
    }
}

__device__ __forceinline__ void stage_combine(const P& p) {
    const int tid_ = ltid(), lane = tid_ & 63, wave = tid_ >> 6, nwv = blockDim.x >> 6;
    const int gw = blockIdx.x * nwv + wave, NGW = gridDim.x * nwv;
    const int* posk = (const int*)(p.ws + WS_POS); const float* topw = (const float*)(p.ws + WS_TOPW);
    const bf16_t* Ys = (const bf16_t*)(p.ws + WS_XS); const float* modO = (const float*)(p.ws + WS_MOD) + 4 * 6144;
    for (int row = gw; row < T; row += NGW) {
        const int b = row >> 12; const int p0 = posk[row * 2], p1 = posk[row * 2 + 1]; const float w0 = topw[row * 2], w1 = topw[row * 2 + 1];
#pragma unroll
        for (int j = 0; j < 4; ++j) { const int col = 4 * lane + 256 * j;
            const u32x2 a = *(const u32x2*)(Ys + (size_t)p0 * 1024 + col), c = *(const u32x2*)(Ys + (size_t)p1 * 1024 + col);
            const f32x4 g = *(const f32x4*)(modO + b * 6144 + 5120 + col);
            f32x4 x = *(const f32x4*)(p.out + (size_t)row * DM + col);
            f32x4 m; m.x = w0 * bf2f(a.x & 0xffffu) + w1 * bf2f(c.x & 0xffffu); m.y = w0 * bf2f(a.x >> 16) + w1 * bf2f(c.x >> 16);
            m.z = w0 * bf2f(a.y & 0xffffu) + w1 * bf2f(c.y & 0xffffu); m.w = w0 * bf2f(a.y >> 16) + w1 * bf2f(c.y >> 16);
            *(f32x4*)(p.out + (size_t)row * DM + col) = x + g * m; }
    }
}


constexpr int NWAVES = 8;
constexpr int RING_BYTES = 131072, LDSCTL_OFF = RING_BYTES, MISC_OFF = LDSCTL_OFF + 320, LDS_BYTES = 147456;
constexpr int CW_BAR = 1024;
typedef __attribute__((address_space(1))) unsigned gu32;
#define RLX_AGENT __ATOMIC_RELAXED, __HIP_MEMORY_SCOPE_AGENT
namespace pg8 {
#define PG8_LAS __attribute__((address_space(3)))
typedef unsigned short bf16_t;
typedef short bf16x8 __attribute__((ext_vector_type(8)));
typedef float f32x4 __attribute__((ext_vector_type(4)));
typedef unsigned u32x4 __attribute__((ext_vector_type(4)));
constexpr int BM = 256, BK = 64, HALF = 128, HTB = HALF * BK * 2  , STAGE_BYTES = 8 * HTB, NXCD = 8, WGM = 8;

__host__ __device__ __forceinline__ int lds_byte(int r, int c) { const int st = (r >> 4) * 2 + (c >> 5), rr = r & 15, cc = c & 31, ob = rr * 64 + cc * 2; return st * 1024 + (ob ^ (((ob >> 9) & 1) << 5)); }
__host__ __device__ __forceinline__ void stage_rc(int b, int& R, int& C) { const int st = b / 1024, sb = b % 1024, swz = sb ^ (((sb >> 9) & 1) << 5); R = (st >> 1) * 16 + swz / 64; C = (st & 1) * 32 + (swz % 64) / 2; }
__host__ __device__ __forceinline__ int perm32(int rho) { const int n = rho >> 4, i = rho & 15; return 8 * (i >> 2) + 4 * n + (i & 3); }

struct Unit { int pm, pn, bt; };
struct Gemm { const bf16_t* A; const bf16_t* Bt; int M, N, K; };

struct StaticOrder {
    int nM, nN, nwg, G, c;
    __host__ __device__ void init(int M, int N, int G_, int c_) { nM = M / BM; nN = N / BM; nwg = nM * nN; G = G_; c = c_; }
    __host__ __device__ bool next(int i, Unit& u) const {
        const long L = (long)i * G + c; if (L >= nwg) return false;
        int wgid = (int)L; { const int q = nwg / NXCD, r = nwg % NXCD, xcd = wgid % NXCD, off = wgid / NXCD; wgid = (xcd < r ? xcd * (q + 1) : r * (q + 1) + (xcd - r) * q) + off; }
        const int nig = WGM * nN, gid = wgid / nig, fm = gid * WGM, gsz = (nM - fm) < WGM ? (nM - fm) : WGM;
        u.pm = fm + ((wgid % nig) % gsz); u.pn = (wgid % nig) / gsz; u.bt = u.pn; return true;
    }
    __device__ __forceinline__ void a_ready(const Unit&) const {}
    __device__ __forceinline__ void done(const Unit&) const {}
};

__device__ __forceinline__ unsigned cvt_pk_bf16(float lo, float hi) { unsigned r; asm volatile("v_cvt_pk_bf16_f32 %0, %1, %2" : "=v"(r) : "v"(lo), "v"(hi)); return r; }
typedef float f32x2 __attribute__((ext_vector_type(2)));
__device__ __forceinline__ f32x2 gelu_pk(f32x2 v) {
    const f32x2 av = __builtin_elementwise_abs(v), d = av * 0.2316418882f + 1.0f;
    f32x2 t; t.x = __builtin_amdgcn_rcpf(d.x); t.y = __builtin_amdgcn_rcpf(d.y);
    f32x2 q = t * 0.5307027145f + (-0.7265760135f); q = q * t + 0.7107068705f; q = q * t + (-0.142248368f); q = q * t + 0.127414796f; q = q * t;
    const f32x2 s = (v * v) * (-0.72134752044f);
    f32x2 e; e.x = __builtin_amdgcn_exp2f(s.x); e.y = __builtin_amdgcn_exp2f(s.y);
    const f32x2 m = v * (q * e), r = v - m;
    f32x2 o; o.x = v.x < 0.f ? m.x : r.x; o.y = v.y < 0.f ? m.y : r.y; return o;
}

template <int ACT  > struct EpiBf16 {
    static constexpr bool PERM = true, AFTER_DRAIN = false; static_assert(ACT == 0 || ACT == 1, "EpiBf16: ACT is 0 (none) or 1 (gelu_pk)");
    bf16_t* O; int ldc; const float* bias; int split_cols; size_t split_stride; float scale0;
    __device__ __forceinline__ void operator()(const f32x4 (&acc)[2][2][4][2], const Unit& u, int wr, int wc, int fr, int fq) const {
        const int row0 = u.pm * BM + wr * 64 + fr; int colt = u.pn * BM; bf16_t* base = O;
        float sc = 1.f; if (split_cols) { const int t = colt / split_cols; base += (size_t)t * split_stride; colt -= t * split_cols; if (t == 0) sc = scale0; }
        const int col0 = colt + wc * 32 + 8 * fq, bcol0 = u.pn * BM + wc * 32 + 8 * fq;
        f32x4 bv[2][2];
#pragma unroll
        for (int bj = 0; bj < 2; ++bj)
#pragma unroll
            for (int n = 0; n < 2; ++n) bv[bj][n] = bias ? *(const f32x4*)(bias + bcol0 + bj * HALF + 4 * n) : (f32x4){0.f, 0.f, 0.f, 0.f};
#pragma unroll
        for (int ai = 0; ai < 2; ++ai)
#pragma unroll
            for (int m = 0; m < 4; ++m) { bf16_t* rowp = base + (size_t)(row0 + ai * HALF + m * 16) * ldc + col0;
#pragma unroll
                for (int bj = 0; bj < 2; ++bj) { f32x4 v0 = acc[ai][bj][m][0] + bv[bj][0], v1 = acc[ai][bj][m][1] + bv[bj][1];
                    if (ACT == 1) { f32x2 a = gelu_pk((f32x2){v0[0], v0[1]}), b = gelu_pk((f32x2){v0[2], v0[3]}), c = gelu_pk((f32x2){v1[0], v1[1]}), d = gelu_pk((f32x2){v1[2], v1[3]});
                        v0 = (f32x4){a.x, a.y, b.x, b.y}; v1 = (f32x4){c.x, c.y, d.x, d.y}; }
                    v0 = v0 * sc; v1 = v1 * sc; u32x4 w; w.x = cvt_pk_bf16(v0[0], v0[1]); w.y = cvt_pk_bf16(v0[2], v0[3]); w.z = cvt_pk_bf16(v1[0], v1[1]); w.w = cvt_pk_bf16(v1[2], v1[3]);
                    *(u32x4*)(rowp + bj * HALF) = w; } }
    }
};

struct EpiResid {
    static constexpr bool PERM = false, AFTER_DRAIN = false;
    const float* base; float* out; const float* gate; int ldc;
    __device__ __forceinline__ void operator()(const f32x4 (&acc)[2][2][4][2], const Unit& u, int wr, int wc, int fr, int fq) const {
        const int row0 = u.pm * BM + wr * 64 + fr, col0 = u.pn * BM + wc * 32 + 4 * fq;
        const float* gb = gate + ((u.pm * BM) >> 12) * 6144 + col0;
        f32x4 gv[2][2];
#pragma unroll
        for (int bj = 0; bj < 2; ++bj)
#pragma unroll
            for (int n = 0; n < 2; ++n) gv[bj][n] = *(const f32x4*)(gb + bj * HALF + n * 16);
#pragma unroll
        for (int ai = 0; ai < 2; ++ai)
#pragma unroll
            for (int m = 0; m < 4; ++m) { const size_t off = (size_t)(row0 + ai * HALF + m * 16) * ldc + col0;
#pragma unroll
                for (int bj = 0; bj < 2; ++bj)
#pragma unroll
                    for (int n = 0; n < 2; ++n) { const f32x4 bs = *(const f32x4*)(base + off + bj * HALF + n * 16); *(f32x4*)(out + off + bj * HALF + n * 16) = bs + gv[bj][n] * acc[ai][bj][m][n]; } }
    }
};
struct EpiSwiglu {
    static constexpr bool PERM = true, AFTER_DRAIN = false;
    bf16_t* O; int ldo;
    __device__ __forceinline__ void operator()(const f32x4 (&acc)[2][2][4][2], const Unit& u, int wr, int wc, int fr, int fq) const {
        const int row0 = u.pm * BM + wr * 64 + fr, hcol0 = u.pn * HALF + wc * 32 + 8 * fq;
#pragma unroll
        for (int ai = 0; ai < 2; ++ai)
#pragma unroll
            for (int m = 0; m < 4; ++m) { bf16_t* rowp = O + (size_t)(row0 + ai * HALF + m * 16) * ldo + hcol0;
                float h[8];
#pragma unroll
                for (int n = 0; n < 2; ++n)
#pragma unroll
                    for (int i = 0; i < 4; ++i) { const float g = acc[ai][0][m][n][i], up = acc[ai][1][m][n][i]; h[4 * n + i] = g * __builtin_amdgcn_rcpf(1.f + __expf(-g)) * up; }
                u32x4 w; w.x = cvt_pk_bf16(h[0], h[1]); w.y = cvt_pk_bf16(h[2], h[3]); w.z = cvt_pk_bf16(h[4], h[5]); w.w = cvt_pk_bf16(h[6], h[7]);
                *(u32x4*)rowp = w; }
    }
};
struct GroupedOrder {
    const int* info; int nM, nN, nwg, G, c;
    __device__ void init(const int* info_, int N, int G_, int c_) { info = info_; nM = __builtin_amdgcn_readfirstlane(info_[0]); nN = N / BM; nwg = nM * nN; G = G_; c = c_; }
    __device__ bool next(int i, Unit& u) const {
        const long L = (long)i * G + c; if (L >= nwg) return false;
        int wgid = (int)L; { const int q = nwg / NXCD, r = nwg % NXCD, xcd = wgid % NXCD, off = wgid / NXCD; wgid = (xcd < r ? xcd * (q + 1) : r * (q + 1) + (xcd - r) * q) + off; }
        const int nig = WGM * nN, gid = wgid / nig, fm = gid * WGM, gsz = (nM - fm) < WGM ? (nM - fm) : WGM;
        u.pm = fm + ((wgid % nig) % gsz); u.pn = (wgid % nig) / gsz; u.bt = __builtin_amdgcn_readfirstlane(info[16 + u.pm]) * nN + u.pn; return true;
    }
    __device__ __forceinline__ void a_ready(const Unit&) const {}
    __device__ __forceinline__ void done(const Unit&) const {}
};

template <class Epi, class Sched, bool ALIGN_EPI = false, bool SP2 = false>
__device__ __forceinline__ void gemm_phase(PG8_LAS unsigned char* lds, const Gemm g, const Sched& S, const Epi& E) {
    const int tid = ltid(), wid = __builtin_amdgcn_readfirstlane(tid >> 6), lane = tid & 63, wr = wid >> 2, wc = wid & 3, fr = lane & 15, fq = lane >> 4;
    const int K = g.K, nt = K / BK;
    unsigned voffA[2], voffB[2];
#pragma unroll
    for (int i = 0; i < 2; ++i) { int R, C; stage_rc(tid * 16 + i * 8192, R, C); const int Rb = Epi::PERM ? ((R & ~31) + perm32(R & 31)) : R;
        voffA[i] = (unsigned)(R * K + C) * 2u; voffB[i] = (unsigned)(Rb * K + C) * 2u; }
    const size_t kstep = (size_t)(BK * 2);
    const size_t hstep = (size_t)HALF * K * 2;
    const size_t tstep = 2 * hstep;
    const unsigned ldsw = (unsigned)wid * 1024u;
    const int aoff = lds_byte(wr * 64 + fr, fq * 8), boff = lds_byte(wc * 32 + fr, fq * 8);
#define PG8_SA(b, h) (((b) * 2 + (h)) * HTB)
#define PG8_SB(b, h) ((4 + (b) * 2 + (h)) * HTB)
#define PG8_STAGE(bufoff, gbase, voff) do { _Pragma("unroll") for (int _i = 0; _i < 2; ++_i) \
        __builtin_amdgcn_global_load_lds((const unsigned*)((const char*)(gbase) + (voff)[_i]), (PG8_LAS unsigned*)(lds + (bufoff) + ldsw + _i * 8192), 16, 0, 0); } while (0)
#define PG8_LDA(dst, b, h) do { _Pragma("unroll") for (int m = 0; m < 4; ++m) _Pragma("unroll") for (int k = 0; k < 2; ++k) dst[m][k] = *(const PG8_LAS bf16x8*)(lds + PG8_SA(b, h) + aoff + m * 2048 + k * 1024); } while (0)
#define PG8_LDB(dst, b, h) do { _Pragma("unroll") for (int n = 0; n < 2; ++n) _Pragma("unroll") for (int k = 0; k < 2; ++k) dst[n][k] = *(const PG8_LAS bf16x8*)(lds + PG8_SB(b, h) + boff + n * 2048 + k * 1024); } while (0)
#define PG8_MMA(ai, bj, At, Bt) do { __builtin_amdgcn_s_setprio(1); _Pragma("unroll") for (int m = 0; m < 4; ++m) _Pragma("unroll") for (int n = 0; n < 2; ++n) _Pragma("unroll") for (int k = 0; k < 2; ++k) \
        acc[ai][bj][m][n] = __builtin_amdgcn_mfma_f32_16x16x32_bf16(Bt[n][k], At[m][k], acc[ai][bj][m][n], 0, 0, 0); __builtin_amdgcn_s_setprio(0); } while (0)
#define PG8_WAIT_V(n) asm volatile("s_waitcnt vmcnt(" #n ")" ::: "memory")
#define PG8_WAIT_L(n) asm volatile("s_waitcnt lgkmcnt(" #n ")" ::: "memory")
#define PG8_BAR __builtin_amdgcn_s_barrier()
#define PG8_SCHED __builtin_amdgcn_sched_barrier(0)
    Unit cur, nxt; int ui = 0;
    if (!S.next(0, cur)) return;
    f32x4 acc[2][2][4][2];
#pragma unroll
    for (int a = 0; a < 2; ++a)
#pragma unroll
        for (int b = 0; b < 2; ++b)
#pragma unroll
            for (int m = 0; m < 4; ++m)
#pragma unroll
                for (int n = 0; n < 2; ++n) acc[a][b][m][n] = (f32x4){0.f, 0.f, 0.f, 0.f};
    bf16x8 At[4][2], B0[2][2], B1[2][2];
    const char* cA = (const char*)g.A + (size_t)cur.pm * tstep; const char* cB = (const char*)g.Bt + (size_t)cur.bt * tstep;
    S.a_ready(cur);
    if constexpr (SP2) {
        PG8_STAGE(PG8_SB(0, 0), cB, voffB); PG8_STAGE(PG8_SB(0, 1), cB + hstep, voffB); PG8_STAGE(PG8_SA(0, 0), cA, voffA); PG8_STAGE(PG8_SA(0, 1), cA + hstep, voffA);
        if (wr == 1) PG8_BAR;
        PG8_WAIT_V(2); PG8_BAR;
        PG8_STAGE(PG8_SB(1, 0), cB + kstep, voffB); PG8_STAGE(PG8_SA(1, 0), cA + kstep, voffA); PG8_STAGE(PG8_SB(1, 1), cB + hstep + kstep, voffB);
        PG8_WAIT_V(6); PG8_BAR;
    } else {
        PG8_STAGE(PG8_SB(0, 0), cB, voffB); PG8_STAGE(PG8_SA(0, 0), cA, voffA); PG8_STAGE(PG8_SB(0, 1), cB + hstep, voffB); PG8_STAGE(PG8_SA(0, 1), cA + hstep, voffA);
        if (wr == 1) PG8_BAR;
        PG8_WAIT_V(4); PG8_BAR;
        PG8_STAGE(PG8_SB(1, 0), cB + kstep, voffB); PG8_STAGE(PG8_SA(1, 0), cA + kstep, voffA); PG8_STAGE(PG8_SB(1, 1), cB + hstep + kstep, voffB);
        PG8_WAIT_V(6); PG8_BAR;
    }
    for (;;) {
        const bool has_next = S.next(ui + 1, nxt);
        const char* nA = has_next ? (const char*)g.A + (size_t)nxt.pm * tstep : cA; const char* nB = has_next ? (const char*)g.Bt + (size_t)nxt.bt * tstep : cB;
        for (int t = 0; t < nt; t += 2) {
            const bool last = (t == nt - 2);
            const char* a1 = cA + (size_t)(t + 1) * kstep;
            const char* a2 = last ? nA : cA + (size_t)(t + 2) * kstep; const char* b2 = last ? nB : cB + (size_t)(t + 2) * kstep;
            const char* a3 = a2 + kstep; const char* b3 = b2 + kstep;
            if (last && has_next) S.a_ready(nxt);
            if constexpr (SP2) {
            PG8_LDB(B0, 0, 0); PG8_LDB(B1, 0, 1); PG8_SCHED; PG8_LDA(At, 0, 0); PG8_STAGE(PG8_SA(1, 1), a1 + hstep, voffA);
            PG8_WAIT_V(8); PG8_WAIT_L(0); PG8_BAR; PG8_MMA(0, 0, At, B0); PG8_MMA(0, 1, At, B1); PG8_BAR; PG8_SCHED;
            PG8_LDA(At, 0, 1); PG8_STAGE(PG8_SB(0, 0), b2, voffB); PG8_STAGE(PG8_SB(0, 1), b2 + hstep, voffB); PG8_STAGE(PG8_SA(0, 0), a2, voffA);
            PG8_WAIT_V(8); PG8_WAIT_L(0); PG8_BAR; PG8_MMA(1, 0, At, B0); PG8_MMA(1, 1, At, B1); PG8_BAR; PG8_SCHED;
            PG8_LDB(B0, 1, 0); PG8_LDB(B1, 1, 1); PG8_SCHED; PG8_LDA(At, 1, 0); PG8_STAGE(PG8_SA(0, 1), a2 + hstep, voffA);
            PG8_WAIT_V(8); PG8_WAIT_L(0); PG8_BAR; PG8_MMA(0, 0, At, B0); PG8_MMA(0, 1, At, B1); PG8_BAR; PG8_SCHED;
            PG8_LDA(At, 1, 1); PG8_STAGE(PG8_SB(1, 0), b3, voffB); PG8_STAGE(PG8_SB(1, 1), b3 + hstep, voffB); PG8_STAGE(PG8_SA(1, 0), a3, voffA);
            PG8_WAIT_V(8); PG8_WAIT_L(0); PG8_BAR; PG8_MMA(1, 0, At, B0); PG8_MMA(1, 1, At, B1); PG8_BAR; PG8_SCHED;
            } else {
            PG8_LDB(B0, 0, 0); PG8_SCHED; PG8_LDA(At, 0, 0); PG8_STAGE(PG8_SA(1, 1), a1 + hstep, voffA);
            PG8_WAIT_L(8); PG8_BAR; PG8_WAIT_L(0); PG8_MMA(0, 0, At, B0); PG8_BAR; PG8_SCHED;
            PG8_LDB(B1, 0, 1); PG8_STAGE(PG8_SB(0, 0), b2, voffB);
            PG8_BAR; PG8_WAIT_L(0); PG8_MMA(0, 1, At, B1); PG8_BAR;
            PG8_LDA(At, 0, 1); PG8_STAGE(PG8_SA(0, 0), a2, voffA);
            PG8_BAR; PG8_WAIT_L(0); PG8_MMA(1, 0, At, B0); PG8_BAR; PG8_SCHED;
            PG8_STAGE(PG8_SB(0, 1), b2 + hstep, voffB);
            PG8_WAIT_V(6); PG8_BAR; PG8_MMA(1, 1, At, B1); PG8_BAR;
            PG8_LDB(B0, 1, 0); PG8_SCHED; PG8_LDA(At, 1, 0); PG8_STAGE(PG8_SA(0, 1), a2 + hstep, voffA);
            PG8_WAIT_L(8); PG8_BAR; PG8_WAIT_L(0); PG8_MMA(0, 0, At, B0); PG8_BAR; PG8_SCHED;
            PG8_LDB(B1, 1, 1); PG8_STAGE(PG8_SB(1, 0), b3, voffB);
            PG8_BAR; PG8_WAIT_L(0); PG8_MMA(0, 1, At, B1); PG8_BAR;
            PG8_LDA(At, 1, 1); PG8_STAGE(PG8_SA(1, 0), a3, voffA);
            PG8_BAR; PG8_WAIT_L(0); PG8_MMA(1, 0, At, B0); PG8_BAR; PG8_SCHED;
            PG8_STAGE(PG8_SB(1, 1), b3 + hstep, voffB);
            PG8_WAIT_V(6); PG8_BAR; PG8_MMA(1, 1, At, B1); PG8_BAR;
            }
        }
        if constexpr (ALIGN_EPI) { if (wr == 0) PG8_BAR; }
        if constexpr (!Epi::AFTER_DRAIN) { E(acc, cur, wr, wc, fr, fq); S.done(cur); }
        if (!has_next) break;
#pragma unroll
        for (int a = 0; a < 2; ++a)
#pragma unroll
            for (int b = 0; b < 2; ++b)
#pragma unroll
                for (int m = 0; m < 4; ++m)
#pragma unroll
                    for (int n = 0; n < 2; ++n) acc[a][b][m][n] = (f32x4){0.f, 0.f, 0.f, 0.f};
        cur = nxt; cA = nA; cB = nB; ++ui;
        if constexpr (ALIGN_EPI) { if (wr == 1) PG8_BAR; }
    }
    PG8_WAIT_V(0);
    if constexpr (!ALIGN_EPI) { if (wr == 0) PG8_BAR; }
    PG8_BAR;
    if constexpr (Epi::AFTER_DRAIN) { E.fused(acc, cur, wr, wc, fr, fq, lds, wid, lane); S.done(cur); }
#undef PG8_SA
#undef PG8_SB
#undef PG8_STAGE
#undef PG8_LDA
#undef PG8_LDB
#undef PG8_MMA
#undef PG8_WAIT_V
#undef PG8_WAIT_L
#undef PG8_BAR
#undef PG8_SCHED
}
}
#include <hip/hip_bf16.h>
#include <cmath>
namespace attn_body {
using bf16=__hip_bfloat16;
using bf16x8=__attribute__((ext_vector_type(8)))short;
using s16x4=__attribute__((ext_vector_type(4)))short;
using f32x16=__attribute__((ext_vector_type(16)))float;
using u32x4=__attribute__((ext_vector_type(4)))unsigned;
constexpr int BATCH=4,NHEAD=8,SEQ=4096,D=64,DM=NHEAD*D,OPITCH=1024,OOFF=512;
constexpr int NW=8,QBLK=32,QB=QBLK*NW,KVBLK=64,NQB=SEQ/QB;
constexpr int ATTN_PITCH=DM, ATTN_UNIT_ROWS=QB;
__device__ __forceinline__ int crow(int r,int hi){return (r&3)+8*(r>>2)+4*hi;}
#define SBAR() __builtin_amdgcn_sched_barrier(0)
__device__ __forceinline__ void cmask(f32x16&p0,f32x16&p1,int jb,int qrel,int hi){
  const float NEG=-INFINITY; const int lim=qrel-64*jb-4*hi;
  #pragma unroll
  for(int r=0;r<16;++r){const int kc=(r&3)+8*(r>>2); if(kc>lim)p0[r]=NEG; if(kc+32>lim)p1[r]=NEG;}
}

__device__ __forceinline__ void smask(f32x16&p0,f32x16&p1,bool sel){
  const float NEG=-INFINITY;
  if(!sel){
    #pragma unroll
    for(int r=0;r<16;++r){p0[r]=NEG;p1[r]=NEG;} }
}
constexpr int NSLOT=3, SLOTB=8192;
constexpr int LDS_K=0, LDS_V=NSLOT*SLOTB, LDS_WS=2*NSLOT*SLOTB, LDS_OST=LDS_WS+NW*64*4, LDS_BYTES=LDS_OST+NW*4096;
constexpr float C2=0.125f*1.4426950408889634f;
__device__ __forceinline__ void glds16(const void*gsrc,unsigned lds_dst){unsigned keep;
  asm volatile("s_mov_b32 %0, m0\n\ts_mov_b32 m0, %2\n\ts_nop 0\n\tglobal_load_lds_dwordx4 %1, off\n\ts_mov_b32 m0, %0":"=&s"(keep):"v"(gsrc),"s"(lds_dst):"memory");}
__device__ __forceinline__ float max3f(float a,float b,float c){float r;asm("v_max3_f32 %0, %1, %2, %3":"=v"(r):"v"(a),"v"(b),"v"(c));return r;}
__device__ __forceinline__ float max2f(float a,float b){float r;asm("v_max_f32_e32 %0, %1, %2":"=v"(r):"v"(a),"v"(b));return r;}
__device__ __forceinline__ float fadd_s(float a,float b){float r;asm("v_add_f32_e32 %0, %1, %2":"=v"(r):"v"(a),"v"(b));return r;}
__device__ __forceinline__ float fsub_s(float a,float b){float r;asm("v_sub_f32_e32 %0, %1, %2":"=v"(r):"v"(a),"v"(b));return r;}
typedef float f32x2_t __attribute__((ext_vector_type(2))); typedef __bf16 bf16x2_t __attribute__((ext_vector_type(2)));
__device__ __forceinline__ unsigned cvtpk_s(float lo,float hi){f32x2_t v={lo,hi};bf16x2_t b=__builtin_convertvector(v,bf16x2_t);return __builtin_bit_cast(unsigned,b);}
#define WAIT_BAR(N) asm volatile("s_waitcnt vmcnt(" #N ") lgkmcnt(0)\n\ts_barrier":::"memory")

__device__ __forceinline__ void qkt(f32x16&p0,f32x16&p1,const char*Kslot,const bf16x8*qr,const f32x16&negm,int r32,int hi){
  const char*kb=Kslot+hi*1024+r32*16;
  #pragma unroll
  for(int d0=0;d0<4;++d0){
    const bf16x8 b0=*reinterpret_cast<const bf16x8*>(kb+d0*2048);
    const bf16x8 b1=*reinterpret_cast<const bf16x8*>(kb+d0*2048+512);
    if(d0==0){p0=__builtin_amdgcn_mfma_f32_32x32x16_bf16(b0,qr[0],negm,0,0,0);p1=__builtin_amdgcn_mfma_f32_32x32x16_bf16(b1,qr[0],negm,0,0,0);}
    else{p0=__builtin_amdgcn_mfma_f32_32x32x16_bf16(b0,qr[d0],p0,0,0,0);p1=__builtin_amdgcn_mfma_f32_32x32x16_bf16(b1,qr[d0],p1,0,0,0);}}
}
typedef __attribute__((address_space(3))) const char* lds_cptr;
typedef short v4i16_t __attribute__((ext_vector_type(4)));
__device__ __forceinline__ void kload8(bf16x8*kf,lds_cptr kp){
  kf[0]=*(const __attribute__((address_space(3))) bf16x8*)(kp);      kf[1]=*(const __attribute__((address_space(3))) bf16x8*)(kp+512);
  kf[2]=*(const __attribute__((address_space(3))) bf16x8*)(kp+2048); kf[3]=*(const __attribute__((address_space(3))) bf16x8*)(kp+2560);
  kf[4]=*(const __attribute__((address_space(3))) bf16x8*)(kp+4096); kf[5]=*(const __attribute__((address_space(3))) bf16x8*)(kp+4608);
  kf[6]=*(const __attribute__((address_space(3))) bf16x8*)(kp+6144); kf[7]=*(const __attribute__((address_space(3))) bf16x8*)(kp+6656);
}
__device__ __forceinline__ void kload2(bf16x8*kf,lds_cptr kp,int j){ kf[2*j]=*(const __attribute__((address_space(3))) bf16x8*)(kp+j*2048); kf[2*j+1]=*(const __attribute__((address_space(3))) bf16x8*)(kp+j*2048+512); }
__device__ __forceinline__ s16x4 vtr(lds_cptr p){ return __builtin_bit_cast(s16x4,__builtin_amdgcn_ds_read_tr16_b64_v4i16((__attribute__((address_space(3))) v4i16_t*)p)); }
__device__ __forceinline__ float rowmax(const f32x16&p0,const f32x16&p1){
  float a=max3f(p0[0],p0[1],p1[0]),b=max3f(p0[2],p0[3],p1[1]);a=max3f(a,p1[2],p1[3]);
  #pragma unroll
  for(int r=4;r<16;r+=4){a=max3f(a,p0[r],p0[r+1]);b=max3f(b,p0[r+2],p0[r+3]);a=max3f(a,p1[r],p1[r+1]);b=max3f(b,p1[r+2],p1[r+3]);}
  const float m=max2f(a,b);
  auto rr=__builtin_amdgcn_permlane32_swap(__float_as_uint(m),__float_as_uint(m),false,false);
  return max2f(__uint_as_float(rr[0]),__uint_as_float(rr[1]));
}
__device__ __forceinline__ void pv(f32x16*o,int vb,bf16x8 pa0,bf16x8 pa1,bf16x8 pa2,bf16x8 pa3){
  #pragma unroll
  for(int d0=0;d0<2;++d0){s16x4 lo[4],hi[4];
    #pragma unroll
    for(int ks=0;ks<4;++ks){
      asm volatile("ds_read_b64_tr_b16 %0,%1 offset:%c2":"=&v"(lo[ks]):"v"(vb),"i"(d0*4096+ks*1024):"memory");
      asm volatile("ds_read_b64_tr_b16 %0,%1 offset:%c2":"=&v"(hi[ks]):"v"(vb),"i"(d0*4096+ks*1024+512):"memory");}
    asm volatile("s_waitcnt lgkmcnt(0)":::"memory");SBAR();
    #define PK(k) (bf16x8){lo[k][0],lo[k][1],lo[k][2],lo[k][3],hi[k][0],hi[k][1],hi[k][2],hi[k][3]}
    o[d0]=__builtin_amdgcn_mfma_f32_32x32x16_bf16(pa0,PK(0),o[d0],0,0,0);
    o[d0]=__builtin_amdgcn_mfma_f32_32x32x16_bf16(pa1,PK(1),o[d0],0,0,0);
    o[d0]=__builtin_amdgcn_mfma_f32_32x32x16_bf16(pa2,PK(2),o[d0],0,0,0);
    o[d0]=__builtin_amdgcn_mfma_f32_32x32x16_bf16(pa3,PK(3),o[d0],0,0,0);
    #undef PK
  }
}

#ifndef ATTN_STORE16
#define ATTN_STORE16(p,v) (*(u32x4*)(p)=(v))
#endif
template<int THRL> __device__ __forceinline__ void attn_unit(int b,int h,int qb,const bf16*Q,const bf16*__restrict__ K,const bf16*__restrict__ V,bf16*O,const float*__restrict__ kpart,char*shm){
  const int tid=ltid(),lane=tid&63,r32=lane&31,hi=lane>>5; const int wid=__builtin_amdgcn_readfirstlane(tid>>6);
  const long rowbase=(long)b*SEQ; const int q0=qb*QB;
  const bf16*Qw=Q+(rowbase+q0+wid*QBLK)*DM+h*D;
  const bf16*Kh=K+rowbase*DM+h*D,*Vh=V+rowbase*DM+h*D;
  const unsigned lds0=(unsigned)(uintptr_t)shm;
  float*wsf=(float*)(shm+LDS_WS)+wid*64;
  const bf16*ksrc=Kh+(long)lane*DM+wid*8;
  const bf16*vsrc=Vh+(long)(16*(wid&3)+(lane>>2))*DM+(wid>>2)*32+(lane&3)*8;
  const unsigned kdst=lds0+LDS_K+wid*1024, vdst=lds0+LDS_V+wid*1024;
  #define KT(t) (((t)<4)?(NT-4+(t)):((t)-4))
  #define DMA_K(t,slot) glds16(ksrc+(long)KT(t)*KVBLK*DM,(unsigned)__builtin_amdgcn_readfirstlane(kdst+(slot)))
  #define DMA_V(t,slot) glds16(vsrc+(long)KT(t)*KVBLK*DM,(unsigned)__builtin_amdgcn_readfirstlane(vdst+(slot)))
  const int vb0=(int)(lds0+LDS_V)+((lane>>4)&1)*32+(lane&3)*8+(4*hi+((lane&15)>>2))*64;
  const char*Kbase=shm+LDS_K; bf16x8 kf[8];
  const lds_cptr shm3=(lds_cptr)shm; const lds_cptr kp0=shm3+LDS_K+hi*1024+r32*16; const lds_cptr vp0=shm3+LDS_V+((lane>>4)&1)*32+(lane&3)*8+(4*hi+((lane&15)>>2))*64;
  const int NT=(q0+QB)/KVBLK;
  DMA_K(0,0);DMA_V(0,0);DMA_K(1,SLOTB);
  bf16x8 qr[4];
  #pragma unroll
  for(int d0=0;d0<4;++d0)qr[d0]=*reinterpret_cast<const bf16x8*>(&Qw[(long)r32*DM+d0*16+hi*8]);
  __attribute__((address_space(3))) unsigned*selw=(__attribute__((address_space(3))) unsigned*)(__attribute__((address_space(3))) char*)(shm3+LDS_BYTES+4096);
  { float*km=(float*)(shm+LDS_BYTES);
    for(int i=tid;i<qb*64;i+=NW*64){ const int n=i>>6,d=i&63; const float*kp=kpart+((long)(b*(SEQ/64)+n*4))*DM+h*D+d; float s=0.f;
      #pragma unroll
      for(int k=0;k<4;++k)s+=kp[(long)k*DM];
      km[i]=s; }
    WAIT_BAR(0);
    float qf[32];
    #pragma unroll
    for(int d0=0;d0<4;++d0){
      #pragma unroll
      for(int j=0;j<8;++j)qf[8*d0+j]=__uint_as_float(((unsigned)(unsigned short)qr[d0][j])<<16); }
    int s0=-1,s1=-1,s2=-1; float g0=-INFINITY,g1=-INFINITY,g2=-INFINITY;
    for(int n=0;n<qb;++n){ const float*kr=km+n*64+8*hi; float g=0.f;
      #pragma unroll
      for(int d0=0;d0<4;++d0){
        #pragma unroll
        for(int j=0;j<8;++j)g+=qf[8*d0+j]*kr[16*d0+j]; }
      { auto rr=__builtin_amdgcn_permlane32_swap(__float_as_uint(g),__float_as_uint(g),false,false); g=__uint_as_float(rr[0])+__uint_as_float(rr[1]); }
      if(g>g0){g2=g1;s2=s1;g1=g0;s1=s0;g0=g;s0=n;} else if(g>g1){g2=g1;s2=s1;g1=g;s1=n;} else if(g>g2){g2=g;s2=n;} }
    selw[tid]=(s0>=0?1u<<s0:0u)|(s1>=0?1u<<s1:0u)|(s2>=0?1u<<s2:0u);
  }
  float mhat=0.f,l_reg=0.f;f32x16 o[2];o[0]=f32x16{};o[1]=f32x16{};f32x16 negm=f32x16{};asm volatile("":"+v"(negm));
  const int qrel=wid*QBLK+r32;
  #define CMASK(P0,P1,t) do{const int t_=(t); if(t_<4)cmask(P0,P1,t_,qrel,hi);}while(0)
  #define SELF(tt) ((((tt)<4)||((selw[tid]>>(((tt)-4)>>2))&1u))?0.f:-INFINITY)
  #define BLKMASK(t) do{const int t_=(t); if(t_>=4&&(t_&3)==0){const float ma_=SELF(t_); _Pragma("unroll") for(int r=0;r<16;++r)negm[r]=ma_-mhat; asm volatile("":"+v"(negm));}}while(0)
  bool resc=false;
  #define START(P0,P1) do{ const float rm=rowmax(P0,P1); resc=false; \
    { const float dl=rm; mhat=fadd_s(mhat,dl); \
      _Pragma("unroll") for(int r=0;r<16;++r){P0[r]=fsub_s(P0[r],dl);P1[r]=fsub_s(P1[r],dl);} \
      _Pragma("unroll") for(int r=0;r<16;++r)negm[r]=-mhat; asm volatile("":"+v"(negm)); } \
    _Pragma("unroll") for(int r=0;r<16;++r)P0[r]=__builtin_amdgcn_exp2f(P0[r]); }while(0)
  #define RESC() do{ if(resc){ asm volatile("s_waitcnt lgkmcnt(0)":::"memory"); \
      _Pragma("unroll") for(int d_=0;d_<2;++d_) _Pragma("unroll") for(int r=0;r<16;++r)o[d_][r]*=wsf[crow(r,hi)]; } }while(0)
  f32x16 pA0,pA1,pB0,pB1;
  int sl_prev=0,sl_cur=0,sl_next=SLOTB;
  #define ROT() do{sl_prev=sl_cur;sl_cur=sl_next;sl_next=(sl_next==(NSLOT-1)*SLOTB)?0:sl_next+SLOTB;}while(0)
  DMA_K(2,2*SLOTB);
  WAIT_BAR(3);
  qkt(pA0,pA1,Kbase,qr,negm,r32,hi);asm volatile("s_nop 15\n\ts_nop 7":"+v"(pA0),"+v"(pA1));CMASK(pA0,pA1,0);
  START(pA0,pA1);
  _Pragma("unroll") for(int r=0;r<16;++r)pA1[r]=__builtin_amdgcn_exp2f(pA1[r]);
  WAIT_BAR(0);
  DMA_K(3,0);DMA_V(1,SLOTB);
  ROT();
  kload8(kf,kp0+sl_cur);
  WAIT_BAR(2);
  s16x4 vlo[8],vhi[8]; u32x4 pw0,pw1,pw2,pw3;
  #define PKW(P,B) cvtpk_s(P[B],P[B+1])
  #define PAF(k) __builtin_bit_cast(bf16x8,pw##k)
  #define VFR(i) (bf16x8){vlo[i][0],vlo[i][1],vlo[i][2],vlo[i][3],vhi[i][0],vhi[i][1],vhi[i][2],vhi[i][3]}
  #define PIN(x) asm volatile("":"+v"(x))
  #define MX3(a,b,c) __builtin_fmaxf(__builtin_fmaxf((a),(b)),(c))
  #define GAPA(MF,A0,A1,A2,A3,W0,W1,PW) do{ MF; sacc+=A0; sacc+=A1; sacc+=A2; sacc+=A3; PIN(sacc); W0; W1; PIN(PW); SBAR(); }while(0)
  #define EX(v) __builtin_amdgcn_exp2f(v)
  #define GAPB(MF,X,B) do{ MF; X[B]=EX(X[B]); X[B+1]=EX(X[B+1]); X[B+2]=EX(X[B+2]); X[B+3]=EX(X[B+3]); PIN(X); SBAR(); }while(0)
  #define VRD(i) do{ vlo[i]=vtr(vp_+(((i)>>2)*4096+((i)&3)*1024)); vhi[i]=vtr(vp_+(((i)>>2)*4096+((i)&3)*1024+512)); }while(0)
  #define KRD(G,j) do{ if(G){ kload2(kf,kp0+sl_next,j); SBAR(); } }while(0)
  #define STEP(C0,C1,P0,P1,t,GK,GV,GL) do{ SBAR(); BLKMASK(t); SBAR(); \
    const lds_cptr vp_=vp0+sl_prev; \
    VRD(0); SBAR(); float sacc=(P0[0]+P0[1]); \
    GAPA(C0=__builtin_amdgcn_mfma_f32_32x32x16_bf16(kf[0],qr[0],negm,0,0,0), P0[2],P0[3],P0[4],P0[5],     pw0[0]=PKW(P0,0), pw0[1]=PKW(P0,2), pw0); \
    VRD(4); SBAR(); GAPA(C1=__builtin_amdgcn_mfma_f32_32x32x16_bf16(kf[1],qr[0],negm,0,0,0), P0[6],P0[7],P0[8],P0[9],     pw0[2]=PKW(P0,4), pw0[3]=PKW(P0,6), pw0); \
    VRD(1); SBAR(); GAPA(C0=__builtin_amdgcn_mfma_f32_32x32x16_bf16(kf[2],qr[1],C0,0,0,0),   P0[10],P0[11],P0[12],P0[13], pw1[0]=PKW(P0,8), pw1[1]=PKW(P0,10), pw1); \
    VRD(5); SBAR(); GAPA(C1=__builtin_amdgcn_mfma_f32_32x32x16_bf16(kf[3],qr[1],C1,0,0,0),   P0[14],P0[15],P1[0],P1[1],   pw1[2]=PKW(P0,12),pw1[3]=PKW(P0,14), pw1); \
    VRD(2); SBAR(); GAPA(C0=__builtin_amdgcn_mfma_f32_32x32x16_bf16(kf[4],qr[2],C0,0,0,0),   P1[2],P1[3],P1[4],P1[5],     pw2[0]=PKW(P1,0), pw2[1]=PKW(P1,2), pw2); \
    VRD(6); SBAR(); GAPA(C1=__builtin_amdgcn_mfma_f32_32x32x16_bf16(kf[5],qr[2],C1,0,0,0),   P1[6],P1[7],P1[8],P1[9],     pw2[2]=PKW(P1,4), pw2[3]=PKW(P1,6), pw2); \
    VRD(3); SBAR(); GAPA(C0=__builtin_amdgcn_mfma_f32_32x32x16_bf16(kf[6],qr[3],C0,0,0,0),   P1[10],P1[11],P1[12],P1[13], pw3[0]=PKW(P1,8), pw3[1]=PKW(P1,10), pw3); \
    VRD(7); SBAR(); GAPA(C1=__builtin_amdgcn_mfma_f32_32x32x16_bf16(kf[7],qr[3],C1,0,0,0),   P1[14],P1[15],0.f,0.f,       pw3[2]=PKW(P1,12),pw3[3]=PKW(P1,14), pw3); \
    l_reg+=sacc; \
    if(GK){DMA_K((t)+3,sl_cur);} if(GV){DMA_V((t)+1,sl_next);} \
    CMASK(C0,C1,t); \
    { float a=MX3(C0[0],C0[1],C1[0]),b=MX3(C0[2],C0[3],C1[1]); a=MX3(a,C1[2],C1[3]); \
      _Pragma("unroll") for(int r=4;r<16;r+=4){a=MX3(a,C0[r],C0[r+1]);b=MX3(b,C0[r+2],C0[r+3]);a=MX3(a,C1[r],C1[r+1]);b=MX3(b,C1[r+2],C1[r+3]);} \
      float rm=__builtin_fmaxf(a,b); { auto rr=__builtin_amdgcn_permlane32_swap(__float_as_uint(rm),__float_as_uint(rm),false,false); rm=__builtin_fmaxf(__uint_as_float(rr[0]),__uint_as_float(rr[1])); } \
      resc=false; \
      if(__builtin_expect(__any(rm>(float)THRL),0)){ const float dl=__builtin_fmaxf(rm,0.f); mhat+=dl; \
        _Pragma("unroll") for(int r=0;r<16;++r){C0[r]-=dl;C1[r]-=dl;} \
        { const float ma2_=SELF((t)); _Pragma("unroll") for(int r=0;r<16;++r)negm[r]=ma2_-mhat; } asm volatile("":"+v"(negm)); \
        const float f=__builtin_amdgcn_exp2f(-dl); l_reg*=f; if(hi==0)wsf[r32]=f; resc=true; } } \
    SBAR(); \
    GAPB(o[0]=__builtin_amdgcn_mfma_f32_32x32x16_bf16(PAF(0),VFR(0),o[0],0,0,0), C0,0); \
    GAPB(o[1]=__builtin_amdgcn_mfma_f32_32x32x16_bf16(PAF(0),VFR(4),o[1],0,0,0), C0,4); \
    KRD(GL,0); GAPB(o[0]=__builtin_amdgcn_mfma_f32_32x32x16_bf16(PAF(1),VFR(1),o[0],0,0,0), C0,8); \
    KRD(GL,1); GAPB(o[1]=__builtin_amdgcn_mfma_f32_32x32x16_bf16(PAF(1),VFR(5),o[1],0,0,0), C0,12); \
    KRD(GL,2); GAPB(o[0]=__builtin_amdgcn_mfma_f32_32x32x16_bf16(PAF(2),VFR(2),o[0],0,0,0), C1,0); \
    KRD(GL,3); GAPB(o[1]=__builtin_amdgcn_mfma_f32_32x32x16_bf16(PAF(2),VFR(6),o[1],0,0,0), C1,4); \
    GAPB(o[0]=__builtin_amdgcn_mfma_f32_32x32x16_bf16(PAF(3),VFR(3),o[0],0,0,0), C1,8); \
    GAPB(o[1]=__builtin_amdgcn_mfma_f32_32x32x16_bf16(PAF(3),VFR(7),o[1],0,0,0), C1,12); \
    }while(0)
  int t=1;
  for(;t+5<NT;t+=2){
    STEP(pB0,pB1,pA0,pA1,t,true,true,true);     WAIT_BAR(2); RESC(); ROT();
    STEP(pA0,pA1,pB0,pB1,t+1,true,true,true);   WAIT_BAR(2); RESC(); ROT();
  }
  #define ENDW(tt) do{ if((tt)+3<NT){WAIT_BAR(2);} else if((tt)+2<NT){WAIT_BAR(1);} else {WAIT_BAR(0);} }while(0)
  for(;t+1<NT;t+=2){
    STEP(pB0,pB1,pA0,pA1,t,(t+3<NT),(t+1<NT),(t+1<NT));       ENDW(t);   RESC(); ROT();
    STEP(pA0,pA1,pB0,pB1,t+1,(t+4<NT),(t+2<NT),(t+2<NT));     ENDW(t+1); RESC(); ROT();
  }
  STEP(pB0,pB1,pA0,pA1,NT-1,false,false,false); RESC();
  { float sacc=pB0[0]+pB0[1]; _Pragma("unroll") for(int r=2;r<16;++r)sacc+=pB0[r]; _Pragma("unroll") for(int r=0;r<16;++r)sacc+=pB1[r]; l_reg+=sacc;
    pw0=(u32x4){PKW(pB0,0),PKW(pB0,2),PKW(pB0,4),PKW(pB0,6)};pw1=(u32x4){PKW(pB0,8),PKW(pB0,10),PKW(pB0,12),PKW(pB0,14)};pw2=(u32x4){PKW(pB1,0),PKW(pB1,2),PKW(pB1,4),PKW(pB1,6)};pw3=(u32x4){PKW(pB1,8),PKW(pB1,10),PKW(pB1,12),PKW(pB1,14)};
    SBAR(); pv(o,vb0+sl_cur,PAF(0),PAF(1),PAF(2),PAF(3)); }
  #undef PKW
  #undef PAF
  #undef VFR
  #undef PIN
  #undef MX3
  #undef GAPA
  #undef GAPB
  #undef EX
  #undef VRD
  #undef KRD
  #undef STEP
  #undef ENDW
  {auto rr=__builtin_amdgcn_permlane32_swap(__float_as_uint(l_reg),__float_as_uint(l_reg),false,false);l_reg=__uint_as_float(rr[0])+__uint_as_float(rr[1]);}
  if(hi==0)wsf[32+r32]=l_reg;asm volatile("s_waitcnt lgkmcnt(0)":::"memory");
  float rli[16];
  #pragma unroll
  for(int r=0;r<16;++r)rli[r]=__builtin_amdgcn_rcpf(wsf[32+crow(r,hi)]);
  bf16*Ow=O+(rowbase+q0+wid*QBLK)*OPITCH+OOFF+h*D;
  { bf16*stg=(bf16*)(shm+LDS_OST)+wid*2048;
    #pragma unroll
    for(int r=0;r<16;++r){const int orow=crow(r,hi);
      #pragma unroll
      for(int d0=0;d0<2;++d0)stg[orow*64+d0*32+r32]=__float2bfloat16(o[d0][r]*rli[r]);}
    asm volatile("s_waitcnt lgkmcnt(0)":::"memory");
    #pragma unroll
    for(int i=0;i<4;++i){const int row=i*8+(lane>>3),ch=lane&7; const u32x4 v=*(const u32x4*)(stg+row*64+ch*8); ATTN_STORE16(Ow+(long)row*OPITCH+ch*8,v);} }
  asm volatile("s_waitcnt lgkmcnt(0)\n\ts_barrier":::"memory");
  #undef DMA_K
  #undef KT
  #undef DMA_V
  #undef CMASK
  #undef SELF
  #undef BLKMASK
  #undef START
  #undef RESC
  #undef ROT
}
constexpr int ATTN_LDS_BYTES=LDS_BYTES;
struct AttnTensors { const bf16* Q; const bf16* K; const bf16* V; bf16* O; const float* kpart; };
struct AttnUnit { int bh; int qb; };
struct StaticOrder {
  int vcu,G;
  __device__ __forceinline__ explicit StaticOrder(int grid,int block):vcu((grid%8==0)?(block%8)*(grid/8)+block/8:block),G(grid){}
  __device__ __forceinline__ bool next(int i,AttnUnit&u)const{ const int j=vcu+i*G; if(j>=512)return false; if(j<256){u.bh=j>>3;u.qb=15-(j&7);} else {u.bh=(j-256)>>3;u.qb=(j-256)&7;} return true; }
  __device__ __forceinline__ void a_ready(const AttnUnit&)const{}
  __device__ __forceinline__ void done(const AttnUnit&)const{}
};
template<class Sched,int THRL=8> __device__ __forceinline__ void attn_phase(char*lds,const AttnTensors&T,const Sched&S){
  AttnUnit u;
  for(int i=0;S.next(i,u);++i){ S.a_ready(u); attn_unit<THRL>(u.bh/NHEAD,u.bh%NHEAD,u.qb,T.Q,T.K,T.V,T.O,T.kpart,lds); S.done(u); }
}
#undef SBAR
#undef WAIT_BAR
}
#define GAS __attribute__((address_space(1)))
#define XB_TMO      128
#define XB_XCNT(j)  (256  + 64 * (j))
#define XB_XSUB(j)  (1280 + 64 * (j))
#define XB_XGEN(j)  (2304 + 64 * (j))
#define XB_TOP      3328
#define XB_TOPGEN   3392
#define XCD_BAR_WORDS 3456
#define XB_SPIN_CAP (1u << 18)

__device__ __forceinline__ unsigned xb_ld(unsigned* p)              { return __hip_atomic_load(p, __ATOMIC_RELAXED, __HIP_MEMORY_SCOPE_AGENT); }
__device__ __forceinline__ unsigned xb_add(unsigned* p, unsigned v) { return __hip_atomic_fetch_add(p, v, __ATOMIC_RELAXED, __HIP_MEMORY_SCOPE_AGENT); }
__device__ __forceinline__ unsigned xb_xcc_id() { return (unsigned)__builtin_amdgcn_s_getreg((3 << 11) | 20) & 0xFu; }
#define XB_SPIN(cond, bar) do { unsigned _sp = 0; while (cond) { __builtin_amdgcn_s_sleep(1); \
    if ((++_sp & 255u) == 0u) { if (xb_ld(&(bar)[XB_TMO])) break; if (_sp > XB_SPIN_CAP) { atomicAdd(&(bar)[XB_TMO], 1u); break; } } } } while (0)

struct XcdBarrier {
    unsigned* bar; unsigned x;
    volatile LAS unsigned* st;
};

__device__ __forceinline__ XcdBarrier xcd_barrier_post(unsigned* bar, volatile LAS unsigned* st) {
    XcdBarrier b; b.bar = bar; b.x = xb_xcc_id(); b.st = st;
    if (threadIdx.x == 0) (void)xb_add(&bar[XB_XCNT(b.x)], 1u);
    return b;
}
__device__ __forceinline__ void xcd_barrier_complete(unsigned* bar, unsigned x, unsigned& nloc, unsigned& nx) {
    const unsigned G = gridDim.x * gridDim.y * gridDim.z;
    unsigned sum, cnt, mine, sp = 0u;
    for (;;) {
        sum = 0u; cnt = 0u; mine = 0u;
#pragma unroll
        for (unsigned j = 0; j < 16; ++j) { const unsigned c = xb_ld(&bar[XB_XCNT(j)]); sum += c; cnt += (c > 0u) ? 1u : 0u; mine = (j == x) ? c : mine; }
        if (sum == G) break;
        __builtin_amdgcn_s_sleep(1);
        if ((++sp & 255u) == 0u) { if (xb_ld(&bar[XB_TMO])) break; if (sp > XB_SPIN_CAP) { atomicAdd(&bar[XB_TMO], 1u); break; } }
    }
    nloc = mine > 0u ? mine : 1u; nx = cnt > 0u ? cnt : 1u;
}

__device__ __forceinline__ void xcd_barrier(const XcdBarrier& b) {
    asm volatile("s_waitcnt vmcnt(0)" ::: "memory");
    __syncthreads();
    if (threadIdx.x == 0) {
        unsigned* bar = b.bar;
        __builtin_amdgcn_s_waitcnt(0);
        unsigned nloc = b.st[0], nx = b.st[1];
        if (nloc == 0u) { xcd_barrier_complete(bar, b.x, nloc, nx); b.st[0] = nloc; b.st[1] = nx; }
        const unsigned old = xb_add(&bar[XB_XSUB(b.x)], 1u);
        const unsigned gen = old / nloc;
        if (old + 1u == (gen + 1u) * nloc) {
            __builtin_amdgcn_fence(__ATOMIC_RELEASE, "agent");
            asm volatile("s_waitcnt vmcnt(0)" ::: "memory");
            const unsigned og = xb_add(&bar[XB_TOP], 1u);
            const unsigned tg = og / nx;
            if (og + 1u == (tg + 1u) * nx) xb_add(&bar[XB_TOPGEN], 1u);
            else XB_SPIN(xb_ld(&bar[XB_TOPGEN]) == tg, bar);
            __builtin_amdgcn_fence(__ATOMIC_ACQUIRE, "agent");
            xb_add(&bar[XB_XGEN(b.x)], 1u);
            asm volatile("s_waitcnt vmcnt(0)" ::: "memory");
        } else {
            XB_SPIN(xb_ld(&bar[XB_XGEN(b.x)]) == gen, bar);
            __builtin_amdgcn_fence(__ATOMIC_ACQUIRE, "agent");
            asm volatile("s_waitcnt vmcnt(0)" ::: "memory");
        }
    }
    __syncthreads();
}

constexpr size_t WT_EIN = WS_WSMALL, WT_EOUT = WT_EIN + 4 * MiB, WT_EUP = WT_EOUT + 2 * MiB, WT_EDN = WT_EUP + 11 * MiB, WT_OIN = WT_EDN + 5 * MiB + 512 * KiB, WT_OOUT = WT_OIN + 6 * MiB;
constexpr size_t WT_MUP = WS_WMOE, WT_MDN = WS_WMOE + 112 * MiB;
static_assert(WT_OOUT + 2 * MiB <= WS_WMOE, "small weights");
__device__ __forceinline__ void cvt_item(const float* W, int K, int N, bf16_t* WT, int dst_row0, int k0, int n0, LAS float* scr, int lane) {
    const int rr = lane >> 3, cc = (lane & 7) * 4;
#pragma unroll
    for (int i = 0; i < 8; ++i) { const int kk = 8 * i + rr; const f32x4 v = *(const f32x4*)(W + (size_t)(k0 + kk) * N + n0 + cc); LAS float* s = scr + kk * 33 + cc; s[0] = v.x; s[1] = v.y; s[2] = v.z; s[3] = v.w; }
    asm volatile("s_waitcnt lgkmcnt(0)" ::: "memory");
    const int c = lane & 7;
#pragma unroll
    for (int j = 0; j < 4; ++j) { const int n = (lane >> 3) + 8 * j; const LAS float* s = scr + (8 * c) * 33 + n;
        u32x4 o; o.x = pk2(s[0 * 33], s[1 * 33]); o.y = pk2(s[2 * 33], s[3 * 33]); o.z = pk2(s[4 * 33], s[5 * 33]); o.w = pk2(s[6 * 33], s[7 * 33]);
        *(u32x4*)(WT + (size_t)(dst_row0 + n) * K + k0 + 8 * c) = o; }
    asm volatile("s_waitcnt lgkmcnt(0)" ::: "memory");
}
__device__ __forceinline__ void cvt_matrix_item(const float* W, int K, int N, bf16_t* WT, int mode, int item, LAS float* scr, int lane) {
    const int nblk = N / 32, kb = item / nblk, nb = item % nblk, n0 = 32 * nb;
    const int dst_row0 = mode == 0 ? n0 : ((n0 >> 7) * 256 + (n0 & 127) + 128 * (mode - 1));
    cvt_item(W, K, N, WT, dst_row0, 64 * kb, n0, scr, lane);
}
__device__ __forceinline__ void stage_convert(const P& p, LAS unsigned char* lds) {
    const int tid_ = ltid(), lane = tid_ & 63, wave = __builtin_amdgcn_readfirstlane(tid_ >> 6);
    LAS float* scr = (LAS float*)(lds + wave * 8448);
    const int gw = blockIdx.x * NWAVES + wave, NGW = gridDim.x * NWAVES;
    constexpr int I_EIN = 16 * 64, I_EOUT = 16 * 32, I_EUP = 16 * 88, I_EDN = 44 * 32, I_OIN = 16 * 96, I_OOUT = 16 * 32, I_MUP = 16 * 112, I_MDN = 56 * 32;
    constexpr int NSMALL = I_EIN + I_EOUT + 2 * I_EUP + I_EDN + I_OIN + I_OOUT, NITEMS = NSMALL + 8 * (2 * I_MUP + I_MDN);
    unsigned char* ws = p.ws;
    for (int it = gw; it < NITEMS; it += NGW) {
        int r = it;
        if (r < I_EIN) { cvt_matrix_item(p.inp(E_W_IN), 1024, 2048, (bf16_t*)(ws + WT_EIN), 0, r, scr, lane); continue; } r -= I_EIN;
        if (r < I_EOUT) { cvt_matrix_item(p.inp(E_W_OUT), 1024, 1024, (bf16_t*)(ws + WT_EOUT), 0, r, scr, lane); continue; } r -= I_EOUT;
        if (r < I_EUP) { cvt_matrix_item(p.inp(E_FFN_WG), 1024, FFN, (bf16_t*)(ws + WT_EUP), 1, r, scr, lane); continue; } r -= I_EUP;
        if (r < I_EUP) { cvt_matrix_item(p.inp(E_FFN_WU), 1024, FFN, (bf16_t*)(ws + WT_EUP), 2, r, scr, lane); continue; } r -= I_EUP;
        if (r < I_EDN) { cvt_matrix_item(p.inp(E_FFN_WD), FFN, 1024, (bf16_t*)(ws + WT_EDN), 0, r, scr, lane); continue; } r -= I_EDN;
        if (r < I_OIN) { cvt_matrix_item(p.inp(O_W_IN), 1024, 3072, (bf16_t*)(ws + WT_OIN), 0, r, scr, lane); continue; } r -= I_OIN;
        if (r < I_OOUT) { cvt_matrix_item(p.inp(O_W_OUT), 1024, 1024, (bf16_t*)(ws + WT_OOUT), 0, r, scr, lane); continue; } r -= I_OOUT;
        const int e = r / (2 * I_MUP + I_MDN); r -= e * (2 * I_MUP + I_MDN);
        if (r < I_MUP) { cvt_matrix_item(p.inp(O_MOE_WG) + (size_t)e * 1024 * ED, 1024, ED, (bf16_t*)(ws + WT_MUP) + (size_t)e * 2 * ED * 1024, 1, r, scr, lane); continue; } r -= I_MUP;
        if (r < I_MUP) { cvt_matrix_item(p.inp(O_MOE_WU) + (size_t)e * 1024 * ED, 1024, ED, (bf16_t*)(ws + WT_MUP) + (size_t)e * 2 * ED * 1024, 2, r, scr, lane); continue; } r -= I_MUP;
        cvt_matrix_item(p.inp(O_MOE_WD) + (size_t)e * ED * 1024, ED, 1024, (bf16_t*)(ws + WT_MDN) + (size_t)e * 1024 * ED, 0, r, scr, lane);
    }
}

#ifndef MK_PER_PHASE
#define MK_PER_PHASE 0
#endif
constexpr int N_PHASES = 19;
__global__ void __launch_bounds__(NWAVES * 64, 2) mega_fwd(const P p) {
    extern __shared__ __attribute__((aligned(16))) unsigned char lds_raw[];
    LAS unsigned char* lds = (LAS unsigned char*)lds_raw;
    volatile LAS unsigned* MISC = (volatile LAS unsigned*)(lds + MISC_OFF);
    const int tid = ltid(), G = gridDim.x;
    for (int u = tid; u < (LDS_BYTES - LDSCTL_OFF) / 4; u += NWAVES * 64) ((LAS unsigned*)(lds + LDSCTL_OFF))[u] = 0u;
    __syncthreads();
#if MK_PER_PHASE
    const int lo = p.ph_lo, hi = p.ph_hi;
#else
    constexpr int lo = 0, hi = N_PHASES;
#endif
    const bool use_bar = (hi - lo) > 1;
    unsigned* ctl = (unsigned*)(p.ws + WS_CTL);
    XcdBarrier bar; bar.bar = ctl + CW_BAR; bar.x = 0; bar.st = nullptr;
    if (use_bar) bar = xcd_barrier_post(ctl + CW_BAR, MISC + 8);
#define IN(k) (lo <= (k) && (k) < hi)
#define SEAM(k) do { if (IN(k) && IN((k) + 1)) xcd_barrier(bar); } while (0)
    unsigned char* ws = p.ws;
    bf16_t* XN = (bf16_t*)(ws + WS_R + R_XN); bf16_t* U = (bf16_t*)(ws + WS_R + R_U); bf16_t* Y = (bf16_t*)(ws + WS_R + R_Y); bf16_t* H = (bf16_t*)(ws + WS_R + R_H);
    bf16_t* Xs = (bf16_t*)(ws + WS_XS); bf16_t* Hs = (bf16_t*)(ws + WS_R + R_HS);
    const float* modE = (const float*)(ws + WS_MOD); const float* modO = modE + 4 * 6144;
    const int* info = (const int*)(ws + WS_EXPINFO);
    typedef pg8::EpiBf16<0> EB;

    if (IN(0)) { stage_prep(p, (LAS float*)lds); __syncthreads(); stage_convert(p, lds); } SEAM(0);
    if (IN(1)) stage_norm<false>(p, p.inp(I_X), p.inp(E_NORM_MIX), modE, 0, 1024, XN); SEAM(1);
    if (IN(2)) { pg8::Gemm g{XN, (const bf16_t*)(ws + WT_EIN), T, 2048, DM}; pg8::StaticOrder S; S.init(T, 2048, G, (int)blockIdx.x);
        EB E{U, 2048, nullptr, 0, 0, 1.f}; pg8::gemm_phase<EB, pg8::StaticOrder, true, true>(lds, g, S, E); } SEAM(2);
    if (IN(3)) stage_griffin_local(p, lds); SEAM(3);
    if (IN(4)) stage_mix0_finish(p, lds); SEAM(4);
    if (IN(5)) { pg8::Gemm g{Y, (const bf16_t*)(ws + WT_EOUT), T, DM, DM}; pg8::StaticOrder S; S.init(T, DM, G, (int)blockIdx.x);
        pg8::EpiResid E{p.inp(I_X), p.out, modE + 2048, DM}; pg8::gemm_phase<pg8::EpiResid, pg8::StaticOrder, true, true>(lds, g, S, E); } SEAM(5);
    if (IN(6)) stage_norm<false>(p, p.out, p.inp(E_NORM_FFN), modE, 3072, 4096, XN); SEAM(6);
    if (IN(7)) { pg8::Gemm g{XN, (const bf16_t*)(ws + WT_EUP), T, 2 * FFN, DM}; pg8::StaticOrder S; S.init(T, 2 * FFN, G, (int)blockIdx.x);
        pg8::EpiSwiglu E{H, FFN}; pg8::gemm_phase<pg8::EpiSwiglu, pg8::StaticOrder, true, true>(lds, g, S, E); } SEAM(7);
    if (IN(8)) { pg8::Gemm g{H, (const bf16_t*)(ws + WT_EDN), T, DM, FFN}; pg8::StaticOrder S; S.init(T, DM, G, (int)blockIdx.x);
        pg8::EpiResid E{p.out, p.out, modE + 5120, DM}; pg8::gemm_phase<pg8::EpiResid, pg8::StaticOrder, true, true>(lds, g, S, E); } SEAM(8);
    if (IN(9)) stage_norm<false>(p, p.out, p.inp(O_NORM_MIX), modO, 0, 1024, XN); SEAM(9);
    if (IN(10)) { pg8::Gemm g{XN, (const bf16_t*)(ws + WT_OIN), T, 3072, DM}; pg8::StaticOrder S; S.init(T, 3072, G, (int)blockIdx.x);
        EB E{U, 3072, nullptr, 0, 0, 1.f}; pg8::gemm_phase<EB, pg8::StaticOrder, true, true>(lds, g, S, E); } SEAM(10);
    if (IN(11)) stage_qkpost(p, (LAS float*)lds); SEAM(11);
    if (IN(12)) { stage_shortconv(p);
        const attn_body::AttnTensors AT{(const attn_body::bf16*)(ws + WS_R + R_Q), (const attn_body::bf16*)(ws + WS_R + R_K), (const attn_body::bf16*)(ws + WS_R + R_V), (attn_body::bf16*)Y, (const float*)(ws + WS_KPART)};
        const attn_body::StaticOrder S(G, (int)blockIdx.x);
        attn_body::attn_phase<attn_body::StaticOrder>((char*)lds_raw, AT, S); } SEAM(12);
    if (IN(13)) { pg8::Gemm g{Y, (const bf16_t*)(ws + WT_OOUT), T, DM, DM}; pg8::StaticOrder S; S.init(T, DM, G, (int)blockIdx.x);
        pg8::EpiResid E{p.out, p.out, modO + 2048, DM}; pg8::gemm_phase<pg8::EpiResid, pg8::StaticOrder, true, true>(lds, g, S, E); } SEAM(13);
    if (IN(14)) stage_norm<true>(p, p.out, p.inp(O_NORM_FFN), modO, 3072, 4096, XN); SEAM(14);
    if (IN(15)) stage_route_assign(p, (LAS int*)lds); SEAM(15);
    if (IN(16)) { pg8::Gemm g{Xs, (const bf16_t*)(ws + WT_MUP), MAXROWS, 2 * ED, DM}; pg8::GroupedOrder S; S.init(info, 2 * ED, G, (int)blockIdx.x);
        pg8::EpiSwiglu E{Hs, ED}; pg8::gemm_phase<pg8::EpiSwiglu, pg8::GroupedOrder, true, true>(lds, g, S, E); } SEAM(16);
    if (IN(17)) { pg8::Gemm g{Hs, (const bf16_t*)(ws + WT_MDN), MAXROWS, DM, ED}; pg8::GroupedOrder S; S.init(info, DM, G, (int)blockIdx.x);
        EB E{Xs, DM, nullptr, 0, 0, 1.f}; pg8::gemm_phase<EB, pg8::GroupedOrder, true, true>(lds, g, S, E); } SEAM(17);
    if (IN(18)) stage_combine(p);
#undef IN
#undef SEAM
}

extern "C" void kernel_launch(void* const* d_in, const int* in_sizes, int n_in, void* d_out, int out_size, void* d_ws, size_t ws_size, hipStream_t stream) {
    static int grid = 0;
    if (grid == 0) {
        if (n_in != N_IN || ws_size < WS_END || out_size != T * DM) { fprintf(stderr, "kernel_launch: n_in %d ws %zu (need %zu) out %d\n", n_in, ws_size, (size_t)WS_END, out_size); grid = -1; return; }
        int dev = 0, cus = 0, per_cu = 0;
        if (hipGetDevice(&dev) != hipSuccess || hipDeviceGetAttribute(&cus, hipDeviceAttributeMultiprocessorCount, dev) != hipSuccess) { grid = -1; return; }
        if (hipFuncSetAttribute((const void*)mega_fwd, hipFuncAttributeMaxDynamicSharedMemorySize, LDS_BYTES) != hipSuccess) { fprintf(stderr, "kernel_launch: hipFuncSetAttribute failed\n"); grid = -1; return; }
        if (hipOccupancyMaxActiveBlocksPerMultiprocessor(&per_cu, (const void*)mega_fwd, NWAVES * 64, LDS_BYTES) != hipSuccess || per_cu < 1) { fprintf(stderr, "kernel_launch: occupancy query says %d\n", per_cu); (void)hipGetLastError(); grid = -1; return; }
        grid = cus;
    }
    if (grid < 0) return;
    (void)hipMemsetAsync((char*)d_ws + WS_CTL, 0, CTL_BYTES, stream);
    P a{};
    for (int i = 0; i < N_IN; ++i) a.in[i] = (const float*)d_in[i];
    a.out = (float*)d_out; a.ws = (unsigned char*)d_ws;
    if (MK_PER_PHASE) { for (int k = 0; k < N_PHASES; ++k) { a.ph_lo = k; a.ph_hi = k + 1; hipLaunchKernelGGL(mega_fwd, dim3(grid), dim3(NWAVES * 64), LDS_BYTES, stream, a); } }
    else { a.ph_lo = 0; a.ph_hi = N_PHASES; hipLaunchKernelGGL(mega_fwd, dim3(grid), dim3(NWAVES * 64), LDS_BYTES, stream, a); }
}
```
